# Optimizing an MI355X kernel written in HIP

```python
import math
import jax, jax.numpy as jnp
from jax import lax
import numpy as np

D_MODEL = 1024
BATCH = 4
SEQ = 8192
DEPTH = 1
DEC_BATCH = 8
DEC_SEQ = 16
PAST_LEN = 2048

CHUNK = 64
Q_BLOCK = 128
HEAD_DIM = 64
FOX_HEADS = 8
DIFF_HEADS = 4
DIFF_VDIM = 2 * HEAD_DIM
FOX_WIDTH = FOX_HEADS * HEAD_DIM
DIFF_QK_WIDTH = DIFF_HEADS * 2 * HEAD_DIM
DIFF_WIDTH = DIFF_HEADS * DIFF_VDIM
MIX_WIDTH = FOX_WIDTH + DIFF_WIDTH
SPLIT_SIZES = (FOX_WIDTH, FOX_WIDTH, FOX_WIDTH, FOX_HEADS, FOX_WIDTH,
               DIFF_QK_WIDTH, DIFF_QK_WIDTH, DIFF_WIDTH, DIFF_WIDTH)
SPLIT_POINTS = tuple(sum(SPLIT_SIZES[:i + 1]) for i in range(len(SPLIT_SIZES) - 1))
IN_WIDTH = sum(SPLIT_SIZES)
DEEPNORM_ALPHA = (2 * DEPTH) ** 0.25
DEEPNORM_BETA = (8 * DEPTH) ** -0.25
FORGET_BIAS_INIT = 3.0
LN_EPS = 1e-5
RMS_EPS = 1e-5
ADA_SCALE = 0.5

kernel_name = "hybrid_fox_diffattn_streaming_step"

F32 = jnp.float32


def layer_norm(x, g, b):
    xf = x.astype(F32)
    mu = jnp.mean(xf, axis=-1, keepdims=True)
    xc = xf - mu
    var = jnp.mean(xc * xc, axis=-1, keepdims=True)
    return (xc * lax.rsqrt(var + LN_EPS) * g.astype(F32) + b.astype(F32)).astype(x.dtype)


def ada_modulation(c, w_ada, b_ada):
    m = jax.nn.silu(c) @ w_ada + b_ada
    shift, scale, gate = jnp.split(m, 3, axis=-1)
    return shift, scale, gate


def in_project(h, w_in, b_f):
    B, T, _ = h.shape
    z = h @ w_in
    fq, fk, fv, ff, fg, dq, dk, dv, dg = jnp.split(z, list(SPLIT_POINTS), axis=-1)

    def heads(t, n, d):
        return t.reshape(B, T, n, d).transpose(0, 2, 1, 3)

    fq = heads(fq, FOX_HEADS, HEAD_DIM)
    fk = heads(fk, FOX_HEADS, HEAD_DIM)
    fv = heads(fv, FOX_HEADS, HEAD_DIM)
    logf = jax.nn.log_sigmoid(ff.astype(F32) + b_f.astype(F32)).transpose(0, 2, 1)
    dq = dq.reshape(B, T, DIFF_HEADS, 2, HEAD_DIM).transpose(0, 2, 1, 3, 4)
    dk = dk.reshape(B, T, DIFF_HEADS, 2, HEAD_DIM).transpose(0, 2, 1, 3, 4)
    dv = heads(dv, DIFF_HEADS, DIFF_VDIM)
    return fq, fk, fv, logf, fg, dq, dk, dv, dg


def fox_attend(q, k, v, cum_q, cum_k, pos_q, pos_k):
    s = jnp.einsum('bhqd,bhkd->bhqk', q, k).astype(F32) * (HEAD_DIM ** -0.5)
    s = s + cum_q[..., :, None] - cum_k[..., None, :]
    mask = pos_k[None, :] <= pos_q[:, None]
    s = jnp.where(mask, s, -jnp.inf)
    p = jax.nn.softmax(s, axis=-1)
    return jnp.einsum('bhqk,bhkd->bhqd', p.astype(v.dtype), v)


def diff_attend(q, k, v, pos_q, pos_k, lam):
    s = jnp.einsum('bhqcd,bhkcd->bhcqk', q, k).astype(F32) * (HEAD_DIM ** -0.5)
    slopes = 2.0 ** (-8.0 * jnp.arange(1, DIFF_HEADS + 1, dtype=F32) / DIFF_HEADS)
    dist = jnp.abs(pos_q[:, None] - pos_k[None, :]).astype(F32)
    s = s - slopes[None, :, None, None, None] * dist
    mask = (pos_k[None, :] // CHUNK) <= (pos_q[:, None] // CHUNK)
    s = jnp.where(mask, s, -jnp.inf)
    p = jax.nn.softmax(s, axis=-1)
    a = p[:, :, 0] - lam * p[:, :, 1]
    return jnp.einsum('bhqk,bhkv->bhqv', a.astype(v.dtype), v)


def diff_lambda(lq1, lk1, lq2, lk2, lam_init):
    return (jnp.exp(jnp.sum(lq1.astype(F32) * lk1.astype(F32)))
            - jnp.exp(jnp.sum(lq2.astype(F32) * lk2.astype(F32))) + lam_init)


def mix_out(fox_o, diff_o, fg, dg, subln_g, lam_init, w_out):
    B, _, T, _ = fox_o.shape
    fox = fox_o.transpose(0, 2, 1, 3).reshape(B, T, FOX_WIDTH)
    df = diff_o.astype(F32)
    df = df * lax.rsqrt(jnp.mean(df * df, axis=-1, keepdims=True) + RMS_EPS)
    df = df * subln_g.astype(F32) * (1.0 - lam_init)
    diff = df.astype(fox.dtype).transpose(0, 2, 1, 3).reshape(B, T, DIFF_WIDTH)
    u = jnp.concatenate([fox * jax.nn.silu(fg), diff * jax.nn.silu(dg)], axis=-1)
    return u @ w_out


def trunk_layer(x, c, p, lam_init, attend):
    shift, scale, gate = ada_modulation(c, p['w_ada'], p['b_ada'])
    h = x * (1.0 + scale[:, None, :]) + shift[:, None, :]
    fq, fk, fv, logf, fg, dq, dk, dv, dg = in_project(h, p['w_in'], p['b_f'])
    lam = diff_lambda(p['lq1'], p['lk1'], p['lq2'], p['lk2'], lam_init)
    fox_o, diff_o = attend(fq, fk, fv, logf, dq, dk, dv, lam)
    branch = mix_out(fox_o, diff_o, fg, dg, p['subln_g'], lam_init, p['w_out'])
    y = layer_norm(DEEPNORM_ALPHA * x + gate[:, None, :] * branch, p['ln_g'], p['ln_b'])
    return y, (fk, fv, logf, dk, dv)


def prompt_attend(fq, fk, fv, logf, dq, dk, dv, lam):
    B, _, S, _ = fq.shape
    nb = S // Q_BLOCK
    pos = jnp.arange(S, dtype=jnp.int32)
    cum = jnp.cumsum(logf, axis=-1)

    def blocks(t):
        t = t.reshape(t.shape[:2] + (nb, Q_BLOCK) + t.shape[3:])
        return jnp.moveaxis(t, 2, 0)

    def unblocks(o):
        o = jnp.moveaxis(o, 0, 2)
        return o.reshape(o.shape[:2] + (S,) + o.shape[4:])

    pos_b = pos.reshape(nb, Q_BLOCK)
    fox_o = lax.map(lambda a: fox_attend(a[0], fk, fv, a[1], cum, a[2], pos),
                    (blocks(fq), blocks(cum), pos_b))
    diff_o = lax.map(lambda a: diff_attend(a[0], dk, dv, a[1], pos, lam),
                     (blocks(dq), pos_b))
    return unblocks(fox_o), unblocks(diff_o)


def make_sample_attend(ck_f, cv_f, clogf, ck_d, cv_d):
    def attend(fq, fk, fv, logf, dq, dk, dv, lam):
        P = ck_f.shape[2]
        T = fq.shape[2]
        fk_all = jnp.concatenate([ck_f.astype(fk.dtype), fk], axis=2)
        fv_all = jnp.concatenate([cv_f.astype(fv.dtype), fv], axis=2)
        cum = jnp.cumsum(jnp.concatenate([clogf.astype(F32), logf], axis=-1), axis=-1)
        dk_all = jnp.concatenate([ck_d.astype(dk.dtype), dk], axis=2)
        dv_all = jnp.concatenate([cv_d.astype(dv.dtype), dv], axis=2)
        pos_k = jnp.arange(P + T, dtype=jnp.int32)
        pos_q = P + jnp.arange(T, dtype=jnp.int32)
        fox_o = fox_attend(fq, fk_all, fv_all, cum[..., P:], cum, pos_q, pos_k)
        diff_o = diff_attend(dq, dk_all, dv_all, pos_q, pos_k, lam)
        return fox_o, diff_o
    return attend


def setup_inputs(seed: int = 0) -> dict:
    key = jax.random.key(seed)
    ks = jax.random.split(key, 24)
    nrm = jax.random.normal
    x_prompt = nrm(ks[0], (BATCH, SEQ, D_MODEL), F32)
    x_sample = nrm(ks[1], (DEC_BATCH, DEC_SEQ, D_MODEL), F32)
    cache_fox_k = nrm(ks[2], (DEPTH, DEC_BATCH, FOX_HEADS, PAST_LEN, HEAD_DIM), F32)
    cache_fox_v = nrm(ks[3], (DEPTH, DEC_BATCH, FOX_HEADS, PAST_LEN, HEAD_DIM), F32)
    cache_fox_logf = jax.nn.log_sigmoid(
        FORGET_BIAS_INIT + nrm(ks[4], (DEPTH, DEC_BATCH, FOX_HEADS, PAST_LEN), F32))
    cache_diff_k = nrm(ks[5], (DEPTH, DEC_BATCH, DIFF_HEADS, PAST_LEN, 2, HEAD_DIM), F32)
    cache_diff_v = nrm(ks[6], (DEPTH, DEC_BATCH, DIFF_HEADS, PAST_LEN, DIFF_VDIM), F32) * DEEPNORM_BETA
    c_prompt = nrm(ks[7], (BATCH, D_MODEL), F32)
    c_sample = nrm(ks[8], (DEC_BATCH, D_MODEL), F32)
    w_ada = nrm(ks[9], (DEPTH, D_MODEL, 3 * D_MODEL), F32) * (ADA_SCALE * D_MODEL ** -0.5)
    b_ada = nrm(ks[10], (DEPTH, 3 * D_MODEL), F32) * 0.02
    col_scale = jnp.concatenate([
        jnp.ones((2 * FOX_WIDTH,), F32),
        jnp.full((FOX_WIDTH,), DEEPNORM_BETA, F32),
        jnp.ones((FOX_HEADS + FOX_WIDTH + 2 * DIFF_QK_WIDTH,), F32),
        jnp.full((DIFF_WIDTH,), DEEPNORM_BETA, F32),
        jnp.ones((DIFF_WIDTH,), F32)])
    w_in = nrm(ks[11], (DEPTH, D_MODEL, IN_WIDTH), F32) * (D_MODEL ** -0.5) * col_scale
    b_f = FORGET_BIAS_INIT + 0.1 * nrm(ks[12], (DEPTH, FOX_HEADS), F32)
    lambda_q1 = 0.1 * nrm(ks[13], (DEPTH, HEAD_DIM), F32)
    lambda_k1 = 0.1 * nrm(ks[14], (DEPTH, HEAD_DIM), F32)
    lambda_q2 = 0.1 * nrm(ks[15], (DEPTH, HEAD_DIM), F32)
    lambda_k2 = 0.1 * nrm(ks[16], (DEPTH, HEAD_DIM), F32)
    subln_g = 1.0 + 0.02 * nrm(ks[17], (DEPTH, DIFF_VDIM), F32)
    w_out = nrm(ks[18], (DEPTH, MIX_WIDTH, D_MODEL), F32) * (MIX_WIDTH ** -0.5) * DEEPNORM_BETA
    ln_g = 1.0 + 0.02 * nrm(ks[19], (DEPTH, D_MODEL), F32)
    ln_b = 0.02 * nrm(ks[20], (DEPTH, D_MODEL), F32)
    return {"x_prompt": x_prompt, "x_sample": x_sample,
            "cache_fox_k": cache_fox_k, "cache_fox_v": cache_fox_v, "cache_fox_logf": cache_fox_logf,
            "cache_diff_k": cache_diff_k, "cache_diff_v": cache_diff_v,
            "c_prompt": c_prompt, "c_sample": c_sample,
            "w_ada": w_ada, "b_ada": b_ada, "w_in": w_in, "b_f": b_f,
            "lambda_q1": lambda_q1, "lambda_k1": lambda_k1, "lambda_q2": lambda_q2, "lambda_k2": lambda_k2,
            "subln_g": subln_g, "w_out": w_out, "ln_g": ln_g, "ln_b": ln_b}


def reference(x_prompt, x_sample, cache_fox_k, cache_fox_v, cache_fox_logf, cache_diff_k, cache_diff_v,
              c_prompt, c_sample, w_ada, b_ada, w_in, b_f, lambda_q1, lambda_k1, lambda_q2, lambda_k2,
              subln_g, w_out, ln_g, ln_b):
    yp = x_prompt
    ys = x_sample
    p_states = ([], [], [], [], [])
    s_states = ([], [], [], [], [])
    for l in range(DEPTH):
        lam_init = 0.8 - 0.6 * math.exp(-0.3 * l)
        p = {'w_ada': w_ada[l], 'b_ada': b_ada[l], 'w_in': w_in[l], 'b_f': b_f[l],
             'lq1': lambda_q1[l], 'lk1': lambda_k1[l], 'lq2': lambda_q2[l], 'lk2': lambda_k2[l],
             'subln_g': subln_g[l], 'w_out': w_out[l], 'ln_g': ln_g[l], 'ln_b': ln_b[l]}
        yp, new_p = trunk_layer(yp, c_prompt, p, lam_init, prompt_attend)
        attend_s = make_sample_attend(cache_fox_k[l], cache_fox_v[l], cache_fox_logf[l],
                                      cache_diff_k[l], cache_diff_v[l])
        ys, new_s = trunk_layer(ys, c_sample, p, lam_init, attend_s)
        for i in range(5):
            p_states[i].append(new_p[i])
            s_states[i].append(new_s[i])
    pk_f, pv_f, plogf, pk_d, pv_d = [jnp.stack(t, axis=0) for t in p_states]
    sk_f, sv_f, slogf, sk_d, sv_d = [jnp.stack(t, axis=0) for t in s_states]
    return (yp, ys, pk_f, pv_f, plogf, pk_d, pv_d, sk_f, sv_f, slogf, sk_d, sv_d)
```

```cpp
#include <hip/hip_runtime.h>
#include <hip/hip_cooperative_groups.h>
#include <cstdio>
#include <cstdint>
#include <type_traits>
namespace cg = cooperative_groups;

#ifndef FUSED
#define FUSED 1
#endif

#ifndef L0_REPS
#define L0_REPS 1
#endif
#ifndef L1_REPS
#define L1_REPS 1
#endif
#ifndef L2_REPS
#define L2_REPS 1
#endif
#ifndef L4_REPS
#define L4_REPS 1
#endif
#ifndef ATTN_REPS
#define ATTN_REPS 1
#endif
#ifndef P0_REPS
#define P0_REPS 1
#endif
#ifndef P1_REPS
#define P1_REPS 1
#endif
#ifndef P2_REPS
#define P2_REPS 1
#endif
#ifndef P4_REPS
#define P4_REPS 1
#endif
#define DI __device__ __forceinline__
typedef unsigned short bf16_t;
typedef short bf16x8 __attribute__((ext_vector_type(8)));
typedef short s16x4 __attribute__((ext_vector_type(4)));
typedef float f32x16 __attribute__((ext_vector_type(16)));
typedef float f32x4 __attribute__((ext_vector_type(4)));
typedef float f32x2 __attribute__((ext_vector_type(2)));
typedef unsigned u32x4 __attribute__((ext_vector_type(4)));
typedef unsigned u32x2 __attribute__((ext_vector_type(2)));
typedef __bf16 bf2_t __attribute__((ext_vector_type(2)));
#define MFMA32(a, b, c) __builtin_amdgcn_mfma_f32_32x32x16_bf16((a), (b), (c), 0, 0, 0)

constexpr int DM = 1024, SEQ = 8192, NB = 4, SB = 8, ST = 16, PAST = 2048;
constexpr int MP = NB * SEQ, MS = SB * ST, MT = MP + MS;
constexpr int SKV = 2112;
constexpr int NWT = 4224;
constexpr float LOG2E = 1.4426950408889634f;
constexpr float QSCALE = 0.125f * LOG2E;
constexpr float ALPHA = 1.189207115002721f;
constexpr int NTHREADS = 256;
constexpr int SMEM_BYTES = 73728;
#ifndef FAST_B2_MAX
#define FAST_B2_MAX 60.f
#endif

constexpr size_t OFF_YP = 0, OFF_YS = 33554432, OFF_PKF = 33685504, OFF_PVF = 50462720, OFF_PLOGF = 67239936, OFF_PKD = 67502080,
                 OFF_PVD = 84279296, OFF_SKF = 101056512, OFF_SVF = 101122048, OFF_SLOGF = 101187584, OFF_SKD = 101188608, OFF_SVD = 101254144;

constexpr size_t al256(size_t x) { return (x + 255) & ~(size_t)255; }
constexpr size_t WS_CTR = 0;
constexpr size_t WS_MOD = 256;
constexpr size_t WS_WTIN = al256(WS_MOD + 12 * 3072 * 4);
constexpr size_t WS_WTOUT = al256(WS_WTIN + (size_t)NWT * 1024 * 2);
constexpr size_t WS_H = al256(WS_WTOUT + (size_t)1024 * 1024 * 2);
constexpr size_t WS_G = al256(WS_H + (size_t)MT * 1024 * 2);
constexpr size_t WS_QF = al256(WS_G + (size_t)MT * 1024 * 2);
constexpr size_t WS_QFS = WS_QF + (size_t)32 * 8192 * 64 * 2;
constexpr size_t WS_KF = al256(WS_QFS + (size_t)64 * 16 * 64 * 2);
constexpr size_t WS_KFS = WS_KF + (size_t)32 * 8192 * 64 * 2;
constexpr size_t WS_VFT = al256(WS_KFS + (size_t)64 * SKV * 64 * 2);
constexpr size_t WS_VFTS = WS_VFT + (size_t)32 * 64 * 8192 * 2;
constexpr size_t WS_LFS = al256(WS_VFTS + (size_t)64 * 64 * SKV * 2);
constexpr size_t WS_QD = al256(WS_LFS + (size_t)64 * SKV * 4);
constexpr size_t WS_QDS = WS_QD + (size_t)16 * 8192 * 128 * 2;
constexpr size_t WS_KD = al256(WS_QDS + (size_t)32 * 16 * 128 * 2);
constexpr size_t WS_KDS = WS_KD + (size_t)16 * 8192 * 128 * 2;
constexpr size_t WS_VDT = al256(WS_KDS + (size_t)32 * SKV * 128 * 2);
constexpr size_t WS_VDTS = WS_VDT + (size_t)16 * 128 * 8192 * 2;
constexpr size_t WS_BAR = al256(WS_VDTS + (size_t)32 * 128 * SKV * 2);
constexpr size_t WS_NRM = WS_BAR + 64 * 256;
constexpr int NRM_FP = 0, NRM_FS = 32, NRM_DP = 96, NRM_DS = 128, NRM_WORDS = 192;
constexpr size_t WS_END = WS_NRM + 1024;

struct Params {
    const float *x_p, *x_s, *ck_f, *cv_f, *clogf, *ck_d, *cv_d, *c_p, *c_s, *w_ada, *b_ada, *w_in, *b_f, *lq1, *lk1, *lq2, *lk2, *subln_g, *w_out, *ln_g, *ln_b;
    float* out;
    char* ws;
};

DI unsigned pk2(float a, float b) { f32x2 v; v.x = a; v.y = b; bf2_t r = __builtin_convertvector(v, bf2_t); return __builtin_bit_cast(unsigned, r); }
DI bf16_t cvt1(float a) { return (bf16_t)(pk2(a, 0.f) & 0xffffu); }
DI float bf2f(unsigned short u) { return __uint_as_float(((unsigned)u) << 16); }
DI float siluf(float v) { return v * __builtin_amdgcn_rcpf(1.f + __builtin_amdgcn_exp2f(-1.4426950408889634f * v)); }
DI float wave_sum(float v) { for (int o = 32; o > 0; o >>= 1) v += __shfl_xor(v, o); return v; }
DI float ex2(float x) { return __builtin_amdgcn_exp2f(x); }

DI float max16(float v) { v = fmaxf(v, __shfl_xor(v, 8)); v = fmaxf(v, __shfl_xor(v, 4)); v = fmaxf(v, __shfl_xor(v, 2)); v = fmaxf(v, __shfl_xor(v, 1)); return v; }
DI void nrm_max(const Params& p, int idx, float v) { atomicMax((unsigned*)(p.ws + WS_NRM) + idx, __float_as_uint(v)); }
DI float sq8(u32x4 a) {
    float s = 0.f, t;
    t = __uint_as_float(a.x << 16); s += t * t; t = __uint_as_float(a.x & 0xffff0000u); s += t * t;
    t = __uint_as_float(a.y << 16); s += t * t; t = __uint_as_float(a.y & 0xffff0000u); s += t * t;
    t = __uint_as_float(a.z << 16); s += t * t; t = __uint_as_float(a.z & 0xffff0000u); s += t * t;
    t = __uint_as_float(a.w << 16); s += t * t; t = __uint_as_float(a.w & 0xffff0000u); s += t * t;
    return s;
}

DI void transpose_tile(const float* __restrict__ src, int ld_src, int ncv, bf16_t* __restrict__ dst, int ld_dst, char* smem) {
    float* t = (float*)smem;
    const int tid = threadIdx.x, tr = tid >> 4, tc = (tid & 15) * 4;
#pragma unroll
    for (int q = 0; q < 4; ++q) {
        const int r = tr + 16 * q;
        f32x4 v = {0.f, 0.f, 0.f, 0.f};
        if (tc < ncv) v = *(const f32x4*)(src + (size_t)r * ld_src + tc);
        t[r * 65 + tc] = v.x; t[r * 65 + tc + 1] = v.y; t[r * 65 + tc + 2] = v.z; t[r * 65 + tc + 3] = v.w;
    }
    __syncthreads();
#pragma unroll
    for (int q = 0; q < 2; ++q) {
        const int ch = tid + 256 * q, c = ch >> 3, rc = (ch & 7) * 8;
        u32x4 o;
        o.x = pk2(t[(rc + 0) * 65 + c], t[(rc + 1) * 65 + c]);
        o.y = pk2(t[(rc + 2) * 65 + c], t[(rc + 3) * 65 + c]);
        o.z = pk2(t[(rc + 4) * 65 + c], t[(rc + 5) * 65 + c]);
        o.w = pk2(t[(rc + 6) * 65 + c], t[(rc + 7) * 65 + c]);
        *(u32x4*)(dst + (size_t)c * ld_dst + rc) = o;
    }
    __syncthreads();
}

constexpr int P0_ADA = 192, P0_WIN = 66 * 16, P0_WOUT = 256, P0_CKF = 2048, P0_CVF = 2048, P0_CLF = 64, P0_CKD = 2048, P0_CVD = 2048;
constexpr int P0_TOTAL = P0_ADA + P0_WIN + P0_WOUT + P0_CKF + P0_CVF + P0_CLF + P0_CKD + P0_CVD;

DI void phase0_item(const Params& p, int it, char* smem) {
    const int tid = threadIdx.x;
    if (it < P0_ADA) {
        float* sc = (float*)smem;
        float* red = (float*)(smem + 49152);
        for (int i = tid; i < 12 * 1024; i += NTHREADS) {
            const int r = i >> 10, k = i & 1023;
            const float c = (r < 4) ? p.c_p[r * 1024 + k] : p.c_s[(r - 4) * 1024 + k];
            sc[i] = siluf(c);
        }
        __syncthreads();
        const int n0 = it * 16, col = tid & 15, kg = tid >> 4;
        float acc[12];
#pragma unroll
        for (int r = 0; r < 12; ++r) acc[r] = 0.f;
#pragma unroll 4
        for (int kk = 0; kk < 64; ++kk) {
            const int k = kg * 64 + kk;
            const float w = p.w_ada[(size_t)k * 3072 + n0 + col];
#pragma unroll
            for (int r = 0; r < 12; ++r) acc[r] += sc[r * 1024 + k] * w;
        }
#pragma unroll
        for (int r = 0; r < 12; ++r) red[(kg * 12 + r) * 16 + col] = acc[r];
        __syncthreads();
        if (tid < 192) {
            const int r = tid >> 4, c2 = tid & 15;
            float s = p.b_ada[n0 + c2];
#pragma unroll
            for (int g = 0; g < 16; ++g) s += red[(g * 12 + r) * 16 + c2];
            ((float*)(p.ws + WS_MOD))[r * 3072 + n0 + c2] = s;
        }
        __syncthreads();
        return;
    }
    it -= P0_ADA;
    if (it < P0_WIN) {
        const int rg = it >> 4, kg = it & 15;
        const int n0 = rg * 64;
        int src_c, ncv = 64;
        if (n0 < 4096) {
            const int seg = n0 >> 9, off = n0 & 511;
            const int segbase = (seg == 0) ? 0 : (seg == 1) ? 512 : (seg == 2) ? 1024 : (seg == 3) ? 1544 : (seg == 4) ? 2056 : (seg == 5) ? 2568 : (seg == 6) ? 3080 : 3592;
            src_c = segbase + off;
        } else if (n0 == 4096) { src_c = 1536; ncv = 8; }
        else { src_c = 1536; ncv = 0; }
        transpose_tile(p.w_in + (size_t)(kg * 64) * 4104 + src_c, 4104, ncv, (bf16_t*)(p.ws + WS_WTIN) + (size_t)n0 * 1024 + kg * 64, 1024, smem);
        return;
    }
    it -= P0_WIN;
    if (it < P0_WOUT) {
        const int rg = it >> 4, kg = it & 15;
        transpose_tile(p.w_out + (size_t)(kg * 64) * 1024 + rg * 64, 1024, 64, (bf16_t*)(p.ws + WS_WTOUT) + (size_t)(rg * 64) * 1024 + kg * 64, 1024, smem);
        return;
    }
    it -= P0_WOUT;
    if (it < P0_CKF) {
        const int bh = it >> 5, r0 = (it & 31) * 64;
        const float* s = p.ck_f + ((size_t)bh * 2048 + r0) * 64;
        bf16_t* d = (bf16_t*)(p.ws + WS_KFS) + ((size_t)bh * SKV + r0) * 64;
        float nm = 0.f;
#pragma unroll
        for (int q = 0; q < 2; ++q) {
            const int e = (tid + 256 * q) * 8;
            const f32x4 a = *(const f32x4*)(s + e), b = *(const f32x4*)(s + e + 4);
            u32x4 o; o.x = pk2(a.x, a.y); o.y = pk2(a.z, a.w); o.z = pk2(b.x, b.y); o.w = pk2(b.z, b.w);
            *(u32x4*)(d + e) = o;
            float ss = (a.x * a.x + a.y * a.y) + (a.z * a.z + a.w * a.w) + (b.x * b.x + b.y * b.y) + (b.z * b.z + b.w * b.w);
            ss += __shfl_xor(ss, 1); ss += __shfl_xor(ss, 2); ss += __shfl_xor(ss, 4);
            nm = fmaxf(nm, ss);
        }
        nm = fmaxf(nm, __shfl_xor(nm, 8)); nm = fmaxf(nm, __shfl_xor(nm, 16)); nm = fmaxf(nm, __shfl_xor(nm, 32));
        if ((tid & 63) == 0) nrm_max(p, NRM_FS + bh, nm);
        return;
    }
    it -= P0_CKF;
    if (it < P0_CVF) {
        const int bh = it >> 5, r0 = (it & 31) * 64;
        transpose_tile(p.cv_f + ((size_t)bh * 2048 + r0) * 64, 64, 64, (bf16_t*)(p.ws + WS_VFTS) + (size_t)bh * 64 * SKV + r0, SKV, smem);
        return;
    }
    it -= P0_CVF;
    if (it < P0_CLF) {
        const float* s = p.clogf + (size_t)it * 2048;
        float* d = (float*)(p.ws + WS_LFS) + (size_t)it * SKV;
#pragma unroll
        for (int q = 0; q < 2; ++q) { const int e = (tid + 256 * q) * 4; *(f32x4*)(d + e) = *(const f32x4*)(s + e); }
        {
            const u32x4 z = {0u, 0u, 0u, 0u};
            bf16_t* vf = (bf16_t*)(p.ws + WS_VFTS) + (size_t)it * 64 * SKV;
            bf16_t* vd = (bf16_t*)(p.ws + WS_VDTS) + ((size_t)(it >> 1) * 128 + (it & 1) * 64) * SKV;
            for (int e = tid; e < 64 * 6; e += NTHREADS) {
                const int r = e / 6, c = e % 6;
                *(u32x4*)(vf + (size_t)r * SKV + 2064 + c * 8) = z;
                *(u32x4*)(vd + (size_t)r * SKV + 2064 + c * 8) = z;
            }
        }
        return;
    }
    it -= P0_CLF;
    if (it < P0_CKD) {
        const int bh = it >> 6, r0 = (it & 63) * 32;
        const float* s = p.ck_d + ((size_t)bh * 2048 + r0) * 128;
        bf16_t* d = (bf16_t*)(p.ws + WS_KDS) + ((size_t)bh * SKV + r0) * 128;
        float nm = 0.f;
#pragma unroll
        for (int q = 0; q < 2; ++q) {
            const int e = (tid + 256 * q) * 8;
            const f32x4 a = *(const f32x4*)(s + e), b = *(const f32x4*)(s + e + 4);
            u32x4 o; o.x = pk2(a.x, a.y); o.y = pk2(a.z, a.w); o.z = pk2(b.x, b.y); o.w = pk2(b.z, b.w);
            *(u32x4*)(d + e) = o;
            float ss = (a.x * a.x + a.y * a.y) + (a.z * a.z + a.w * a.w) + (b.x * b.x + b.y * b.y) + (b.z * b.z + b.w * b.w);
            ss += __shfl_xor(ss, 1); ss += __shfl_xor(ss, 2); ss += __shfl_xor(ss, 4);
            nm = fmaxf(nm, ss);
        }
        nm = fmaxf(nm, __shfl_xor(nm, 16)); nm = fmaxf(nm, __shfl_xor(nm, 32));
        if ((tid & 55) == 0) nrm_max(p, NRM_DS + bh * 2 + ((tid >> 3) & 1), nm);
        return;
    }
    it -= P0_CKD;
    {
        const int bh = it >> 6, rem = it & 63, r0 = (rem >> 1) * 64, dh = rem & 1;
        transpose_tile(p.cv_d + ((size_t)bh * 2048 + r0) * 128 + dh * 64, 128, 64, (bf16_t*)(p.ws + WS_VDTS) + ((size_t)bh * 128 + dh * 64) * SKV + r0, SKV, smem);
    }
}

DI void phase1_item(const Params& p, int it) {
    const int tid = threadIdx.x, tok0 = it * 16;
    const float* x; int r12;
    if (tok0 < MP) { x = p.x_p + (size_t)tok0 * 1024; r12 = tok0 >> 13; }
    else { x = p.x_s + (size_t)(tok0 - MP) * 1024; r12 = 4 + ((tok0 - MP) >> 4); }
    const float* mod = (const float*)(p.ws + WS_MOD) + r12 * 3072;
    const f32x4 sh = *(const f32x4*)(mod + tid * 4), sc = *(const f32x4*)(mod + 1024 + tid * 4);
    bf16_t* h = (bf16_t*)(p.ws + WS_H) + (size_t)tok0 * 1024;
#pragma unroll
    for (int r0 = 0; r0 < 16; r0 += 8) {
        f32x4 v[8];
#pragma unroll
        for (int r = 0; r < 8; ++r) v[r] = *(const f32x4*)(x + (r0 + r) * 1024 + tid * 4);
#pragma unroll
        for (int r = 0; r < 8; ++r) {
            u32x2 o;
            o.x = pk2(v[r].x * (1.f + sc.x) + sh.x, v[r].y * (1.f + sc.y) + sh.y);
            o.y = pk2(v[r].z * (1.f + sc.z) + sh.z, v[r].w * (1.f + sc.w) + sh.w);
            *(u32x2*)(h + (r0 + r) * 1024 + tid * 4) = o;
        }
    }
}

template <int BM, int BN, int WGM, bool SWAP>
DI void gemm_mainloop(const bf16_t* __restrict__ A, const bf16_t* __restrict__ B, char* smem, f32x16 (&acc)[2][2]) {
    constexpr int NA = BM / 32, NBC = BN / 32, LDR = 144;
    const int tid = threadIdx.x, lane = tid & 63, wave = tid >> 6, l31 = lane & 31, hh = lane >> 5;
    const int wm = wave % WGM, wn = wave / WGM;
    char* sA = smem; char* sB = smem + BM * LDR;
    u32x4 ra[NA], rb[NBC];
    const int crow_ = tid >> 3, ck = (tid & 7) * 8;
#pragma unroll
    for (int c = 0; c < NA; ++c) ra[c] = *(const u32x4*)(A + (size_t)(crow_ + 32 * c) * 1024 + ck);
#pragma unroll
    for (int c = 0; c < NBC; ++c) rb[c] = *(const u32x4*)(B + (size_t)(crow_ + 32 * c) * 1024 + ck);
#pragma unroll
    for (int i = 0; i < 2; ++i)
#pragma unroll
        for (int j = 0; j < 2; ++j)
#pragma unroll
            for (int r = 0; r < 16; ++r) acc[i][j][r] = 0.f;
    const int aoff = (wm * 64 + l31) * LDR + hh * 16, boff = (wn * 64 + l31) * LDR + hh * 16;
    for (int k0 = 0; k0 < 1024; k0 += 64) {
        __syncthreads();
#pragma unroll
        for (int c = 0; c < NA; ++c) *(u32x4*)(sA + (crow_ + 32 * c) * LDR + ck * 2) = ra[c];
#pragma unroll
        for (int c = 0; c < NBC; ++c) *(u32x4*)(sB + (crow_ + 32 * c) * LDR + ck * 2) = rb[c];
        __syncthreads();
        if (k0 + 64 < 1024) {
#pragma unroll
            for (int c = 0; c < NA; ++c) ra[c] = *(const u32x4*)(A + (size_t)(crow_ + 32 * c) * 1024 + k0 + 64 + ck);
#pragma unroll
            for (int c = 0; c < NBC; ++c) rb[c] = *(const u32x4*)(B + (size_t)(crow_ + 32 * c) * 1024 + k0 + 64 + ck);
        }
#pragma unroll
        for (int s = 0; s < 4; ++s) {
            bf16x8 a0 = *(const bf16x8*)(sA + aoff + s * 32), a1 = *(const bf16x8*)(sA + aoff + 32 * LDR + s * 32);
            bf16x8 b0 = *(const bf16x8*)(sB + boff + s * 32), b1 = *(const bf16x8*)(sB + boff + 32 * LDR + s * 32);
            if constexpr (SWAP) {
                acc[0][0] = MFMA32(b0, a0, acc[0][0]);
                acc[0][1] = MFMA32(b1, a0, acc[0][1]);
                acc[1][0] = MFMA32(b0, a1, acc[1][0]);
                acc[1][1] = MFMA32(b1, a1, acc[1][1]);
            } else {
                acc[0][0] = MFMA32(a0, b0, acc[0][0]);
                acc[0][1] = MFMA32(a0, b1, acc[0][1]);
                acc[1][0] = MFMA32(a1, b0, acc[1][0]);
                acc[1][1] = MFMA32(a1, b1, acc[1][1]);
            }
        }
    }
}

template <bool SWAP>
DI void gemm_mainloop_db(const bf16_t* __restrict__ A, const bf16_t* __restrict__ B, char* smem, f32x16 (&acc)[2][2]) {
    constexpr int LDR = 144, STAGE = 256 * LDR;
    const int tid = threadIdx.x, lane = tid & 63, wave = tid >> 6, l31 = lane & 31, hh = lane >> 5;
    const int wm = wave & 1, wn = wave >> 1;
    u32x4 ra[4], rb[4];
    const int crow_ = tid >> 3, ck = (tid & 7) * 8;
    const bf16_t* Ap = A + (size_t)crow_ * 1024 + ck;
    const bf16_t* Bp = B + (size_t)crow_ * 1024 + ck;
    const int woff = crow_ * LDR + ck * 2;
#pragma unroll
    for (int c = 0; c < 4; ++c) { ra[c] = *(const u32x4*)(Ap + (size_t)(32 * c) * 1024); rb[c] = *(const u32x4*)(Bp + (size_t)(32 * c) * 1024); }
#pragma unroll
    for (int i = 0; i < 2; ++i)
#pragma unroll
        for (int j = 0; j < 2; ++j)
#pragma unroll
            for (int r = 0; r < 16; ++r) acc[i][j][r] = 0.f;
#pragma unroll
    for (int c = 0; c < 4; ++c) { *(u32x4*)(smem + woff + 32 * c * LDR) = ra[c]; *(u32x4*)(smem + 128 * LDR + woff + 32 * c * LDR) = rb[c]; }
#pragma unroll
    for (int c = 0; c < 4; ++c) { ra[c] = *(const u32x4*)(Ap + (size_t)(32 * c) * 1024 + 64); rb[c] = *(const u32x4*)(Bp + (size_t)(32 * c) * 1024 + 64); }
    __syncthreads();
    const int aoff = (wm * 64 + l31) * LDR + hh * 16, boff = 128 * LDR + (wn * 64 + l31) * LDR + hh * 16;
#pragma unroll 1
    for (int kt = 0; kt < 16; ++kt) {
        const char* sb = smem + (kt & 1) * STAGE;
#pragma unroll
        for (int s = 0; s < 4; ++s) {
            bf16x8 a0 = *(const bf16x8*)(sb + aoff + s * 32), a1 = *(const bf16x8*)(sb + aoff + 32 * LDR + s * 32);
            bf16x8 b0 = *(const bf16x8*)(sb + boff + s * 32), b1 = *(const bf16x8*)(sb + boff + 32 * LDR + s * 32);
            if constexpr (SWAP) {
                acc[0][0] = MFMA32(b0, a0, acc[0][0]);
                acc[0][1] = MFMA32(b1, a0, acc[0][1]);
                acc[1][0] = MFMA32(b0, a1, acc[1][0]);
                acc[1][1] = MFMA32(b1, a1, acc[1][1]);
            } else {
                acc[0][0] = MFMA32(a0, b0, acc[0][0]);
                acc[0][1] = MFMA32(a0, b1, acc[0][1]);
                acc[1][0] = MFMA32(a1, b0, acc[1][0]);
                acc[1][1] = MFMA32(a1, b1, acc[1][1]);
            }
        }
        if (kt + 1 < 16) {
            char* sw = smem + ((kt + 1) & 1) * STAGE;
#pragma unroll
            for (int c = 0; c < 4; ++c) { *(u32x4*)(sw + woff + 32 * c * LDR) = ra[c]; *(u32x4*)(sw + 128 * LDR + woff + 32 * c * LDR) = rb[c]; }
            if (kt + 2 < 16) {
#pragma unroll
                for (int c = 0; c < 4; ++c) { ra[c] = *(const u32x4*)(Ap + (size_t)(32 * c) * 1024 + (kt + 2) * 64); rb[c] = *(const u32x4*)(Bp + (size_t)(32 * c) * 1024 + (kt + 2) * 64); }
            }
        }
        __syncthreads();
    }
}

DI float logsigmoidf(float x) { return fminf(x, 0.f) - log1pf(__expf(-fabsf(x))); }

DI u32x2 pk4(float a, float b, float c, float d) { u32x2 r; r.x = pk2(a, b); r.y = pk2(c, d); return r; }
DI u32x4 widen_pair(u32x2 a, u32x2 b) {
    auto r0 = __builtin_amdgcn_permlane32_swap(a.x, b.x, false, false);
    auto r1 = __builtin_amdgcn_permlane32_swap(a.y, b.y, false, false);
    u32x4 o; o.x = r0[0]; o.y = r1[0]; o.z = r0[1]; o.w = r1[1];
    return o;
}
template <bool SWAP>
DI void gemm_mainloop_w(const bf16_t* __restrict__ A, const bf16_t* __restrict__ B, char* smem, f32x16 (&acc)[2][4]) {
    constexpr int LDR = 80, STAGE = 384 * LDR;
    const int tid = threadIdx.x, lane = tid & 63, wave = tid >> 6, l31 = lane & 31, hh = lane >> 5;
    const int wm = wave & 1, wn = wave >> 1;
    u32x4 ra[2], rb[4];
    const int t2 = tid >> 2, crow_ = (t2 & ~7) | ((t2 >> 1) & 3) | ((t2 & 1) << 2), ck = (tid & 3) * 8;
    const bf16_t* Ap = A + (size_t)crow_ * 1024 + ck;
    const bf16_t* Bp = B + (size_t)crow_ * 1024 + ck;
    const int woff = crow_ * LDR + ck * 2;
#pragma unroll
    for (int c = 0; c < 2; ++c) ra[c] = *(const u32x4*)(Ap + (size_t)(64 * c) * 1024);
#pragma unroll
    for (int c = 0; c < 4; ++c) rb[c] = *(const u32x4*)(Bp + (size_t)(64 * c) * 1024);
#pragma unroll
    for (int i = 0; i < 2; ++i)
#pragma unroll
        for (int j = 0; j < 4; ++j)
#pragma unroll
            for (int r = 0; r < 16; ++r) acc[i][j][r] = 0.f;
#pragma unroll
    for (int c = 0; c < 2; ++c) *(u32x4*)(smem + woff + 64 * c * LDR) = ra[c];
#pragma unroll
    for (int c = 0; c < 4; ++c) *(u32x4*)(smem + 128 * LDR + woff + 64 * c * LDR) = rb[c];
#pragma unroll
    for (int c = 0; c < 2; ++c) ra[c] = *(const u32x4*)(Ap + (size_t)(64 * c) * 1024 + 32);
#pragma unroll
    for (int c = 0; c < 4; ++c) rb[c] = *(const u32x4*)(Bp + (size_t)(64 * c) * 1024 + 32);
    __syncthreads();
    const int aoff = (wm * 64 + l31) * LDR + hh * 16, boff = 128 * LDR + (wn * 128 + l31) * LDR + hh * 16;
#pragma unroll 1
    for (int kt = 0; kt < 32; ++kt) {
        const char* sb = smem + (kt & 1) * STAGE;
#pragma unroll
        for (int s = 0; s < 2; ++s) {
            const bf16x8 a0 = *(const bf16x8*)(sb + aoff + s * 32), a1 = *(const bf16x8*)(sb + aoff + 32 * LDR + s * 32);
#pragma unroll
            for (int j = 0; j < 4; ++j) {
                const bf16x8 bj = *(const bf16x8*)(sb + boff + j * 32 * LDR + s * 32);
                if constexpr (SWAP) { acc[0][j] = MFMA32(bj, a0, acc[0][j]); acc[1][j] = MFMA32(bj, a1, acc[1][j]); }
                else { acc[0][j] = MFMA32(a0, bj, acc[0][j]); acc[1][j] = MFMA32(a1, bj, acc[1][j]); }
            }
        }
        if (kt + 1 < 32) {
            char* sw = smem + ((kt + 1) & 1) * STAGE;
#pragma unroll
            for (int c = 0; c < 2; ++c) *(u32x4*)(sw + woff + 64 * c * LDR) = ra[c];
#pragma unroll
            for (int c = 0; c < 4; ++c) *(u32x4*)(sw + 128 * LDR + woff + 64 * c * LDR) = rb[c];
            if (kt + 2 < 32) {
#pragma unroll
                for (int c = 0; c < 2; ++c) ra[c] = *(const u32x4*)(Ap + (size_t)(64 * c) * 1024 + (kt + 2) * 32);
#pragma unroll
                for (int c = 0; c < 4; ++c) rb[c] = *(const u32x4*)(Bp + (size_t)(64 * c) * 1024 + (kt + 2) * 32);
            }
        }
        __syncthreads();
    }
}

template <int SEG, int NJ>
DI void inproj_epi(const Params& p, f32x16 (&acc)[2][NJ], int mt, int nt, int wm, int wn, int l31, int hh) {
    float* out = p.out; char* ws = p.ws;
    const bool smp = (mt == 256);
    const int T = smp ? ST : SEQ;
    const int lane_ = l31 + 32 * hh;
    if constexpr (SEG == 2 || SEG == 6 || SEG == 8) {
#pragma unroll
        for (int i = 0; i < 2; ++i)
#pragma unroll
            for (int j = 0; j < NJ; ++j) {
                const int c = (nt & 3) * 128 + wn * (NJ * 32) + j * 32 + l31;
#pragma unroll
                for (int g = 0; g < 4; ++g) {
                    const int rl = wm * 64 + i * 32 + 8 * g + 4 * hh;
                    int b, t;
                    if (!smp) { b = mt >> 6; t = (mt & 63) * 128 + rl; } else { b = rl >> 4; t = rl & 15; }
                    const float v0 = acc[i][j][4 * g], v1 = acc[i][j][4 * g + 1], v2 = acc[i][j][4 * g + 2], v3 = acc[i][j][4 * g + 3];
                    if constexpr (SEG == 2) {
                        const int head = c >> 6, d = c & 63;
                        float* o = out + (smp ? OFF_SVF : OFF_PVF) + ((size_t)(b * 8 + head) * T + t) * 64 + d;
                        o[0] = v0; o[64] = v1; o[128] = v2; o[192] = v3;
                    } else if constexpr (SEG == 6) {
                        const int head = c >> 7, cd = c & 127;
                        float* o = out + (smp ? OFF_SVD : OFF_PVD) + ((size_t)(b * 4 + head) * T + t) * 128 + cd;
                        o[0] = v0; o[128] = v1; o[256] = v2; o[384] = v3;
                    } else {
                        if (wn == 0 && j == 0 && l31 < 8) {
                            const int head = l31;
                            const float bf = p.b_f[head];
                            f32x4 lf; lf.x = logsigmoidf(v0 + bf); lf.y = logsigmoidf(v1 + bf); lf.z = logsigmoidf(v2 + bf); lf.w = logsigmoidf(v3 + bf);
                            *(f32x4*)(out + (smp ? OFF_SLOGF : OFF_PLOGF) + (size_t)(b * 8 + head) * T + t) = lf;
                            if (smp) *(f32x4*)((float*)(ws + WS_LFS) + (size_t)(b * 8 + head) * SKV + PAST + t) = lf;
                        }
                    }
                }
                if constexpr (SEG == 2 || SEG == 6) {
#pragma unroll
                    for (int g = 0; g < 4; g += 2) {
                        const u32x4 w = widen_pair(pk4(acc[i][j][4 * g], acc[i][j][4 * g + 1], acc[i][j][4 * g + 2], acc[i][j][4 * g + 3]),
                                                   pk4(acc[i][j][4 * g + 4], acc[i][j][4 * g + 5], acc[i][j][4 * g + 6], acc[i][j][4 * g + 7]));
                        const int rl = wm * 64 + i * 32 + 8 * g + 8 * hh;
                        int b, t;
                        if (!smp) { b = mt >> 6; t = (mt & 63) * 128 + rl; } else { b = rl >> 4; t = rl & 15; }
                        bf16_t* vt;
                        if constexpr (SEG == 2) {
                            const int head = c >> 6, d = c & 63;
                            vt = smp ? (bf16_t*)(ws + WS_VFTS) + ((size_t)(b * 8 + head) * 64 + d) * SKV + PAST + t
                                     : (bf16_t*)(ws + WS_VFT) + ((size_t)(b * 8 + head) * 64 + d) * SEQ + t;
                        } else {
                            const int head = c >> 7, cd = c & 127;
                            vt = smp ? (bf16_t*)(ws + WS_VDTS) + ((size_t)(b * 4 + head) * 128 + cd) * SKV + PAST + t
                                     : (bf16_t*)(ws + WS_VDT) + ((size_t)(b * 4 + head) * 128 + cd) * SEQ + t;
                        }
                        *(u32x4*)vt = w;
                    }
                }
            }
    } else {
#pragma unroll
        for (int i = 0; i < 2; ++i) {
            const int rl = wm * 64 + i * 32 + l31;
            int b, t;
            if (!smp) { b = mt >> 6; t = (mt & 63) * 128 + rl; } else { b = rl >> 4; t = rl & 15; }
            const size_t tok = (size_t)mt * 128 + rl;
            if constexpr (SEG == 1 || SEG == 5) {
#pragma unroll
                for (int jp = 0; jp < NJ / 2; ++jp) {
                    float ss = 0.f;
#pragma unroll
                    for (int j = 2 * jp; j < 2 * jp + 2; ++j)
#pragma unroll
                        for (int r = 0; r < 16; ++r) ss += acc[i][j][r] * acc[i][j][r];
                    ss += __shfl_xor(ss, 32);
                    ss = max16(ss);
                    if ((lane_ & 47) == 0) {
                        const int c0 = (nt & 3) * 128 + wn * (NJ * 32) + jp * 64;
                        if constexpr (SEG == 1) nrm_max(p, (smp ? NRM_FS : NRM_FP) + b * 8 + (c0 >> 6), ss);
                        else nrm_max(p, (smp ? NRM_DS : NRM_DP) + (b * 4 + (c0 >> 7)) * 2 + ((c0 >> 6) & 1), ss);
                    }
                }
            }
#pragma unroll
            for (int j = 0; j < NJ; ++j) {
                if constexpr (SEG == 1 || SEG == 5) {
#pragma unroll
                    for (int g = 0; g < 4; ++g) {
                        const int c = (nt & 3) * 128 + wn * (NJ * 32) + j * 32 + 8 * g + 4 * hh;
                        f32x4 w; w.x = acc[i][j][4 * g]; w.y = acc[i][j][4 * g + 1]; w.z = acc[i][j][4 * g + 2]; w.w = acc[i][j][4 * g + 3];
                        float* o;
                        if constexpr (SEG == 1) o = out + (smp ? OFF_SKF : OFF_PKF) + ((size_t)(b * 8 + (c >> 6)) * T + t) * 64 + (c & 63);
                        else o = out + (smp ? OFF_SKD : OFF_PKD) + ((size_t)(b * 4 + (c >> 7)) * T + t) * 128 + (c & 127);
                        *(f32x4*)o = w;
                    }
                }
#pragma unroll
                for (int g = 0; g < 4; g += 2) {
                    float v[8];
#pragma unroll
                    for (int e = 0; e < 8; ++e) v[e] = acc[i][j][4 * g + e];
                    if constexpr (SEG == 0 || SEG == 4) {
#pragma unroll
                        for (int e = 0; e < 8; ++e) v[e] *= QSCALE;
                    } else if constexpr (SEG == 3 || SEG == 7) {
#pragma unroll
                        for (int e = 0; e < 8; ++e) v[e] = siluf(v[e]);
                    }
                    const u32x4 w = widen_pair(pk4(v[0], v[1], v[2], v[3]), pk4(v[4], v[5], v[6], v[7]));
                    const int c = (nt & 3) * 128 + wn * (NJ * 32) + j * 32 + 8 * g + 8 * hh;
                    bf16_t* dst;
                    if constexpr (SEG == 0) dst = (bf16_t*)(ws + (smp ? WS_QFS : WS_QF)) + ((size_t)(b * 8 + (c >> 6)) * T + t) * 64 + (c & 63);
                    else if constexpr (SEG == 1) dst = smp ? (bf16_t*)(ws + WS_KFS) + ((size_t)(b * 8 + (c >> 6)) * SKV + PAST + t) * 64 + (c & 63)
                                                           : (bf16_t*)(ws + WS_KF) + ((size_t)(b * 8 + (c >> 6)) * SEQ + t) * 64 + (c & 63);
                    else if constexpr (SEG == 3 || SEG == 7) dst = (bf16_t*)(ws + WS_G) + tok * 1024 + (SEG == 7 ? 512 : 0) + c;
                    else if constexpr (SEG == 4) dst = (bf16_t*)(ws + (smp ? WS_QDS : WS_QD)) + ((size_t)(b * 4 + (c >> 7)) * T + t) * 128 + (c & 127);
                    else dst = smp ? (bf16_t*)(ws + WS_KDS) + ((size_t)(b * 4 + (c >> 7)) * SKV + PAST + t) * 128 + (c & 127)
                                   : (bf16_t*)(ws + WS_KD) + ((size_t)(b * 4 + (c >> 7)) * SEQ + t) * 128 + (c & 127);
                    *(u32x4*)dst = w;
                }
            }
        }
    }
}

DI void phase2_tile(const Params& p, int mt, int nt, char* smem) {
    const int tid = threadIdx.x, lane = tid & 63, wave = tid >> 6, l31 = lane & 31, hh = lane >> 5, wm = wave & 1, wn = wave >> 1;
    f32x16 acc[2][2];
    gemm_mainloop_db<false>((const bf16_t*)(p.ws + WS_H) + (size_t)mt * 128 * 1024, (const bf16_t*)(p.ws + WS_WTIN) + (size_t)nt * 128 * 1024, smem, acc);
    inproj_epi<8, 2>(p, acc, mt, nt, wm, wn, l31, hh);
}

DI void phase2_tile_w(const Params& p, int mt, int nt, char* smem) {
    int tid_ = threadIdx.x;
    asm volatile("" : "+v"(tid_));
    const int tid = tid_, lane = tid & 63, wave = tid >> 6, l31 = lane & 31, hh = lane >> 5, wm = wave & 1, wn = wave >> 1;
    f32x16 acc[2][4];
    const bf16_t* A = (const bf16_t*)(p.ws + WS_H) + (size_t)mt * 128 * 1024;
    const bf16_t* B = (const bf16_t*)(p.ws + WS_WTIN) + (size_t)nt * 128 * 1024;
    const int seg = nt >> 2;
    if (seg == 2 || seg == 6) {
        gemm_mainloop_w<false>(A, B, smem, acc);
        if (seg == 2) inproj_epi<2, 4>(p, acc, mt, nt, wm, wn, l31, hh);
        else inproj_epi<6, 4>(p, acc, mt, nt, wm, wn, l31, hh);
    } else {
        gemm_mainloop_w<true>(A, B, smem, acc);
        switch (seg) {
            case 0: inproj_epi<0, 4>(p, acc, mt, nt, wm, wn, l31, hh); break;
            case 1: inproj_epi<1, 4>(p, acc, mt, nt, wm, wn, l31, hh); break;
            case 3: inproj_epi<3, 4>(p, acc, mt, nt, wm, wn, l31, hh); break;
            case 4: inproj_epi<4, 4>(p, acc, mt, nt, wm, wn, l31, hh); break;
            case 5: inproj_epi<5, 4>(p, acc, mt, nt, wm, wn, l31, hh); break;
            default: inproj_epi<7, 4>(p, acc, mt, nt, wm, wn, l31, hh); break;
        }
    }
}

constexpr int P2_PER_X = 512 + 32 + 3;
DI int phase2_decode(int v, int q, int& mt, int& nt) {
    if (q < 512) { const int r = q >> 6, lb = q & 63; mt = 32 * v + 8 * (r >> 1) + (lb & 7); nt = 2 * (8 * (r & 1) + (lb >> 3)); return 1; }
    if (q < 544) { mt = 32 * v + (q - 512); nt = 32; return 2; }
    const int k = q - 544;
    mt = 256;
    if (k < 2) { nt = 2 * (v + 8 * k); return 1; }
    if (v == 0) { nt = 32; return 2; }
    return 0;
}

DI bf16x8 pack8(const f32x16& x, int s) {
    u32x4 r;
    r.x = pk2(x[8 * s + 0], x[8 * s + 1]); r.y = pk2(x[8 * s + 2], x[8 * s + 3]);
    r.z = pk2(x[8 * s + 4], x[8 * s + 5]); r.w = pk2(x[8 * s + 6], x[8 * s + 7]);
    return __builtin_bit_cast(bf16x8, r);
}
DI bf16x8 ldv_frag(const char* base) {
    const u32x2 lo = *(const u32x2*)base, hi = *(const u32x2*)(base + 16);
    u32x4 r; r.x = lo.x; r.y = lo.y; r.z = hi.x; r.w = hi.y;
    return __builtin_bit_cast(bf16x8, r);
}

DI void fox_item(const Params& p, char* smem, int smp, int b, int h, int qb) {
    int tid_ = threadIdx.x;
    asm volatile("" : "+v"(tid_));
    const int tid = tid_, lane = tid & 63, wave = tid >> 6, l31 = lane & 31, hh = lane >> 5;
    const int bh = b * 8 + h;
    const bf16_t *Q, *K, *Vt; const float* lf; int ldv, qpos0, nq; size_t tok0;
    if (!smp) {
        Q = (const bf16_t*)(p.ws + WS_QF) + ((size_t)bh * SEQ + qb * 128) * 64; K = (const bf16_t*)(p.ws + WS_KF) + (size_t)bh * SEQ * 64;
        Vt = (const bf16_t*)(p.ws + WS_VFT) + (size_t)bh * 64 * SEQ; ldv = SEQ; lf = p.out + OFF_PLOGF + (size_t)bh * SEQ;
        qpos0 = qb * 128; nq = 128; tok0 = (size_t)b * SEQ + qb * 128;
    } else {
        Q = (const bf16_t*)(p.ws + WS_QFS) + (size_t)bh * 16 * 64; K = (const bf16_t*)(p.ws + WS_KFS) + (size_t)bh * SKV * 64;
        Vt = (const bf16_t*)(p.ws + WS_VFTS) + (size_t)bh * 64 * SKV; ldv = SKV; lf = (const float*)(p.ws + WS_LFS) + (size_t)bh * SKV;
        qpos0 = PAST; nq = 16; tok0 = (size_t)MP + b * 16;
    }
    const int nkv = qpos0 + nq, ntiles = (nkv + 63) >> 6;
    float* cum = (float*)smem;
    char* bufs = smem + 32768;
    float* wsum = (float*)(smem + 32768 + 2 * 18432);
    {
        const int base = tid * 32;
        float s = 0.f;
        if (base < nkv) {
#pragma unroll
            for (int e = 0; e < 8; ++e) {
                if (base + 4 * e < nkv) { const f32x4 v = *(const f32x4*)(lf + base + 4 * e); s += (v.x + v.y) + (v.z + v.w); }
            }
        }
        float inc = s;
#pragma unroll
        for (int o = 1; o < 64; o <<= 1) { const float u = __shfl_up(inc, o); if (lane >= o) inc += u; }
        if (lane == 63) wsum[wave] = inc;
        __syncthreads();
        float run = inc - s;
        for (int w = 0; w < wave; ++w) run += wsum[w];
        if (base < ntiles * 64) {
#pragma unroll
            for (int e = 0; e < 8; ++e) {
                f32x4 v = {0.f, 0.f, 0.f, 0.f};
                if (base + 4 * e < nkv) v = *(const f32x4*)(lf + base + 4 * e);
                f32x4 o;
                run += v.x; o.x = run * LOG2E; run += v.y; o.y = run * LOG2E; run += v.z; o.z = run * LOG2E; run += v.w; o.w = run * LOG2E;
                *(f32x4*)(cum + base + 4 * e) = o;
            }
        }
        __syncthreads();
    }
    const int qrow = min(wave * 32 + l31, nq - 1), qpos = qpos0 + qrow;
    const int wave_qmin = qpos0 + min(wave * 32, nq - 1), wave_qmax = qpos0 + min(wave * 32 + 31, nq - 1);
    bf16x8 qf[4];
#pragma unroll
    for (int s = 0; s < 4; ++s) qf[s] = *(const bf16x8*)(Q + (size_t)qrow * 64 + 16 * s + 8 * hh);
    const float cumq = cum[qpos];
    float B2;
    {
        float ss = 0.f;
#pragma unroll
        for (int s = 0; s < 4; ++s) ss += sq8(__builtin_bit_cast(u32x4, qf[s]));
        ss += __shfl_xor(ss, 32);
        ss = max16(ss); ss = fmaxf(ss, __shfl_xor(ss, 16));
        if (lane == 0) wsum[4 + wave] = ss;
        __syncthreads();
        const float q2 = fmaxf(fmaxf(wsum[4], wsum[5]), fmaxf(wsum[6], wsum[7]));
        const float k2 = __uint_as_float(((const unsigned*)(p.ws + WS_NRM))[(smp ? NRM_FS : NRM_FP) + bh]);
        B2 = 1.02f * sqrtf(q2 * k2) + 0.5f;
    }
    const bool robust = (B2 > FAST_B2_MAX);
    const float thr = robust ? -150.f - 2.f * B2 : -150.f;
    const float cumq0 = cum[qpos0];
    float ref = B2;
    f32x16 O[2];
    float lsum = 0.f;
    const int ldrow = tid >> 3, ldk = (tid & 7) * 8;
    u32x4 kreg[2], vreg[2];
    auto load_tile = [&](int j) {
        const int k0 = j * 64;
#pragma unroll
        for (int c = 0; c < 2; ++c) {
            kreg[c] = *(const u32x4*)(K + (size_t)(k0 + ldrow + 32 * c) * 64 + ldk);
            vreg[c] = *(const u32x4*)(Vt + (size_t)(ldrow + 32 * c) * ldv + k0 + ldk);
        }
    };
    auto run_pass = [&](auto prepass_tag) {
        constexpr bool PRE = decltype(prepass_tag)::value;
        const float cq = PRE ? cumq : cumq - ref;
        float mrow = -INFINITY;
        load_tile(ntiles - 1);
        int buf = 0;
        for (int j = ntiles - 1; j >= 0; --j, buf ^= 1) {
            char* sK = bufs + buf * 18432; char* sV = sK + 9216;
#pragma unroll
            for (int c = 0; c < 2; ++c) {
                *(u32x4*)(sK + (ldrow + 32 * c) * 144 + ldk * 2) = kreg[c];
                { char* wv = sV + (ldrow + 32 * c) * 136 + ldk * 2; u32x2 lo, hi; lo.x = vreg[c].x; lo.y = vreg[c].y; hi.x = vreg[c].z; hi.y = vreg[c].w;
                  *(u32x2*)wv = lo; *(u32x2*)(wv + 8) = hi; }
            }
            if (j > 0) load_tile(j - 1);
            __syncthreads();
            const int k0 = j * 64;
            if (!PRE && k0 + 63 < qpos0 && (cumq0 - cum[k0 + 63]) < thr) break;
            if (k0 <= wave_qmax) {
                f32x16 X[2];
#pragma unroll
                for (int sub = 0; sub < 2; ++sub)
#pragma unroll
                    for (int g = 0; g < 4; ++g) {
                        const f32x4 ck = *(const f32x4*)(cum + k0 + 32 * sub + 8 * g + 4 * hh);
                        X[sub][4 * g] = cq - ck.x; X[sub][4 * g + 1] = cq - ck.y; X[sub][4 * g + 2] = cq - ck.z; X[sub][4 * g + 3] = cq - ck.w;
                    }
#pragma unroll
                for (int sub = 0; sub < 2; ++sub)
#pragma unroll
                    for (int s = 0; s < 4; ++s) {
                        const bf16x8 kf = *(const bf16x8*)(sK + (32 * sub + l31) * 144 + s * 32 + hh * 16);
                        X[sub] = MFMA32(kf, qf[s], X[sub]);
                    }
                if (k0 + 63 > wave_qmin) {
#pragma unroll
                    for (int sub = 0; sub < 2; ++sub)
#pragma unroll
                        for (int r = 0; r < 16; ++r)
                            if (k0 + 32 * sub + 8 * (r >> 2) + 4 * hh + (r & 3) > qpos) X[sub][r] = -INFINITY;
                }
                if constexpr (PRE) {
#pragma unroll
                    for (int r = 0; r < 16; ++r) mrow = fmaxf(fmaxf(mrow, X[0][r]), X[1][r]);
                } else {
                    float ps = 0.f;
#pragma unroll
                    for (int sub = 0; sub < 2; ++sub)
#pragma unroll
                        for (int r = 0; r < 16; ++r) { const float pv = ex2(X[sub][r]); X[sub][r] = pv; ps += pv; }
                    lsum += ps;
#pragma unroll
                    for (int sub = 0; sub < 2; ++sub)
#pragma unroll
                        for (int s = 0; s < 2; ++s) {
                            const bf16x8 pf = pack8(X[sub], s);
#pragma unroll
                            for (int dt = 0; dt < 2; ++dt) {
                                const bf16x8 vf = ldv_frag(sV + (32 * dt + l31) * 136 + (32 * sub + 16 * s + 4 * hh) * 2);
                                O[dt] = MFMA32(vf, pf, O[dt]);
                            }
                        }
                }
            }
        }
        return mrow;
    };
    if (robust) {
        const float mr = run_pass(std::true_type{});
        ref = fmaxf(mr, __shfl_xor(mr, 32));
        __syncthreads();
    }
#pragma unroll
    for (int dt = 0; dt < 2; ++dt)
#pragma unroll
        for (int r = 0; r < 16; ++r) O[dt][r] = 0.f;
    run_pass(std::false_type{});
    const float l = lsum + __shfl_xor(lsum, 32), inv = 1.f / l;
    if (wave * 32 + l31 < nq) {
        const size_t tok = tok0 + wave * 32 + l31;
        const bf16_t* gp = (const bf16_t*)(p.ws + WS_G) + tok * 1024 + h * 64;
        bf16_t* up = (bf16_t*)(p.ws + WS_H) + tok * 1024 + h * 64;
#pragma unroll
        for (int dt = 0; dt < 2; ++dt)
#pragma unroll
            for (int g = 0; g < 4; ++g) {
                const int d0 = 32 * dt + 8 * g + 4 * hh;
                const u32x2 gg = *(const u32x2*)(gp + d0);
                const float g0 = __uint_as_float(gg.x << 16), g1 = __uint_as_float(gg.x & 0xffff0000u), g2 = __uint_as_float(gg.y << 16), g3 = __uint_as_float(gg.y & 0xffff0000u);
                u32x2 o;
                o.x = pk2(O[dt][4 * g] * inv * g0, O[dt][4 * g + 1] * inv * g1);
                o.y = pk2(O[dt][4 * g + 2] * inv * g2, O[dt][4 * g + 3] * inv * g3);
                *(u32x2*)(up + d0) = o;
            }
    }
    __syncthreads();
}

DI void diff_item(const Params& p, char* smem, int smp, int b, int h, int qb, float lam) {
    int tid_ = threadIdx.x;
    asm volatile("" : "+v"(tid_));
    const int tid = tid_, lane = tid & 63, wave = tid >> 6, l31 = lane & 31, hh = lane >> 5;
    const int rg = wave >> 1, cm = wave & 1;
    const int bh = b * 4 + h;
    const bf16_t *Q, *K, *Vt; int ldv, qpos0, nq, nkv; size_t tok0;
    if (!smp) {
        Q = (const bf16_t*)(p.ws + WS_QD) + ((size_t)bh * SEQ + qb * 64) * 128; K = (const bf16_t*)(p.ws + WS_KD) + (size_t)bh * SEQ * 128;
        Vt = (const bf16_t*)(p.ws + WS_VDT) + (size_t)bh * 128 * SEQ; ldv = SEQ; qpos0 = qb * 64; nq = 64; nkv = qpos0 + 64; tok0 = (size_t)b * SEQ + qb * 64;
    } else {
        Q = (const bf16_t*)(p.ws + WS_QDS) + (size_t)bh * 16 * 128; K = (const bf16_t*)(p.ws + WS_KDS) + (size_t)bh * SKV * 128;
        Vt = (const bf16_t*)(p.ws + WS_VDTS) + (size_t)bh * 128 * SKV; ldv = SKV; qpos0 = PAST; nq = 16; nkv = PAST + 16; tok0 = (size_t)MP + b * 16;
    }
    const int ntiles = (nkv + 63) >> 6;
    const float slope2 = ex2(-2.f * (float)(h + 1)) * LOG2E;
    const int qrow = min(rg * 32 + l31, nq - 1), qpos = qpos0 + qrow;
    bf16x8 qf[4];
#pragma unroll
    for (int s = 0; s < 4; ++s) qf[s] = *(const bf16x8*)(Q + (size_t)qrow * 128 + cm * 64 + 16 * s + 8 * hh);
    float B2;
    {
        float* scr = (float*)(smem + 71680);
        float ss = 0.f;
#pragma unroll
        for (int s = 0; s < 4; ++s) ss += sq8(__builtin_bit_cast(u32x4, qf[s]));
        ss += __shfl_xor(ss, 32);
        ss = max16(ss); ss = fmaxf(ss, __shfl_xor(ss, 16));
        if (lane == 0) scr[wave] = ss;
        __syncthreads();
        const float q2 = fmaxf(fmaxf(scr[0], scr[1]), fmaxf(scr[2], scr[3]));
        const unsigned* nk = (const unsigned*)(p.ws + WS_NRM) + (smp ? NRM_DS : NRM_DP) + bh * 2;
        const float k2 = fmaxf(__uint_as_float(nk[0]), __uint_as_float(nk[1]));
        B2 = 1.02f * sqrtf(q2 * k2) + 0.5f;
    }
    const bool robust = (B2 > FAST_B2_MAX);
    const float thr = robust ? -150.f - 2.f * B2 : -150.f;
    float ref = B2;
    f32x16 O[4];
    float lsum = 0.f;
    u32x4 kreg[4], vreg[4];
    const int krow_ = tid >> 4, kck = (tid & 15) * 8, vrow_ = tid >> 3, vck = (tid & 7) * 8;
    auto load_tile = [&](int j) {
        const int k0 = j * 64;
#pragma unroll
        for (int c = 0; c < 4; ++c) {
            kreg[c] = *(const u32x4*)(K + (size_t)(k0 + krow_ + 16 * c) * 128 + kck);
            vreg[c] = *(const u32x4*)(Vt + (size_t)(vrow_ + 32 * c) * ldv + k0 + vck);
        }
    };
    auto run_pass = [&](auto prepass_tag) {
        constexpr bool PRE = decltype(prepass_tag)::value;
        const float rf = PRE ? 0.f : ref;
        float mrow = -INFINITY;
        load_tile(ntiles - 1);
        int buf = 0;
        for (int j = ntiles - 1; j >= 0; --j, buf ^= 1) {
            char* sK = smem + buf * 35840; char* sV = sK + 17408;
#pragma unroll
            for (int c = 0; c < 4; ++c) {
                *(u32x4*)(sK + (krow_ + 16 * c) * 272 + kck * 2) = kreg[c];
                { char* wv = sV + (vrow_ + 32 * c) * 136 + vck * 2; u32x2 lo, hi; lo.x = vreg[c].x; lo.y = vreg[c].y; hi.x = vreg[c].z; hi.y = vreg[c].w;
                  *(u32x2*)wv = lo; *(u32x2*)(wv + 8) = hi; }
            }
            if (j > 0) load_tile(j - 1);
            __syncthreads();
            const int k0 = j * 64;
            if (!PRE && k0 + 63 < qpos0 && -slope2 * (float)(qpos0 - (k0 + 63)) < thr) break;
            const bool diag = (k0 + 63 >= qpos0);
            f32x16 X[2];
            if (!diag) {
                float bb = slope2 * (float)(k0 + 4 * hh - qpos) - rf;
                const float s2 = slope2 + slope2, s3 = s2 + slope2, s8 = 8.f * slope2;
#pragma unroll
                for (int sub = 0; sub < 2; ++sub)
#pragma unroll
                    for (int g = 0; g < 4; ++g) {
                        X[sub][4 * g] = bb; X[sub][4 * g + 1] = bb + slope2; X[sub][4 * g + 2] = bb + s2; X[sub][4 * g + 3] = bb + s3;
                        bb += s8;
                    }
            } else {
#pragma unroll
                for (int sub = 0; sub < 2; ++sub)
#pragma unroll
                    for (int r = 0; r < 16; ++r) X[sub][r] = 0.f;
            }
#pragma unroll
            for (int sub = 0; sub < 2; ++sub)
#pragma unroll
                for (int s = 0; s < 4; ++s) {
                    const bf16x8 kf = *(const bf16x8*)(sK + (32 * sub + l31) * 272 + cm * 128 + s * 32 + hh * 16);
                    X[sub] = MFMA32(kf, qf[s], X[sub]);
                }
            if (diag) {
                const bool need_mask = (k0 + 64 > nkv);
                float qd = (float)(qpos - k0 - 4 * hh);
#pragma unroll
                for (int sub = 0; sub < 2; ++sub)
#pragma unroll
                    for (int g = 0; g < 4; ++g) {
#pragma unroll
                        for (int e = 0; e < 4; ++e) {
                            float x = X[sub][4 * g + e] - slope2 * fabsf(qd - (float)e) - rf;
                            if (need_mask && (k0 + 4 * hh + 32 * sub + 8 * g + e >= nkv)) x = -INFINITY;
                            X[sub][4 * g + e] = x;
                        }
                        qd -= 8.f;
                    }
            }
            if constexpr (PRE) {
#pragma unroll
                for (int r = 0; r < 16; ++r) mrow = fmaxf(fmaxf(mrow, X[0][r]), X[1][r]);
            } else {
                float ps = 0.f;
#pragma unroll
                for (int sub = 0; sub < 2; ++sub)
#pragma unroll
                    for (int r = 0; r < 16; ++r) { const float pv = ex2(X[sub][r]); X[sub][r] = pv; ps += pv; }
                lsum += ps;
#pragma unroll
                for (int sub = 0; sub < 2; ++sub)
#pragma unroll
                    for (int s = 0; s < 2; ++s) {
                        const bf16x8 pf = pack8(X[sub], s);
#pragma unroll
                        for (int dt = 0; dt < 4; ++dt) {
                            const bf16x8 vf = ldv_frag(sV + (32 * dt + l31) * 136 + (32 * sub + 16 * s + 4 * hh) * 2);
                            O[dt] = MFMA32(vf, pf, O[dt]);
                        }
                    }
            }
        }
        return mrow;
    };
    if (robust) {
        const float mr = run_pass(std::true_type{});
        ref = fmaxf(mr, __shfl_xor(mr, 32));
        __syncthreads();
    }
#pragma unroll
    for (int dt = 0; dt < 4; ++dt)
#pragma unroll
        for (int r = 0; r < 16; ++r) O[dt][r] = 0.f;
    run_pass(std::false_type{});
    const float L = lsum + __shfl_xor(lsum, 32);
    __syncthreads();
    float* xch = (float*)smem + (size_t)rg * 4096;
    if (cm == 1) {
        const float i1 = lam / L;
#pragma unroll
        for (int dt = 0; dt < 4; ++dt)
#pragma unroll
            for (int r = 0; r < 16; ++r) xch[(dt * 16 + r) * 64 + lane] = O[dt][r] * i1;
    }
    __syncthreads();
    if (cm == 0) {
        const float i0 = 1.f / L;
        float ss = 0.f;
#pragma unroll
        for (int dt = 0; dt < 4; ++dt)
#pragma unroll
            for (int r = 0; r < 16; ++r) { const float o = O[dt][r] * i0 - xch[(dt * 16 + r) * 64 + lane]; O[dt][r] = o; ss += o * o; }
        ss += __shfl_xor(ss, 32);
        const float rs = rsqrtf(ss * (1.f / 128.f) + 1e-5f) * 0.8f;
        if (rg * 32 + l31 < nq) {
            const size_t tok = tok0 + rg * 32 + l31;
            const bf16_t* gp = (const bf16_t*)(p.ws + WS_G) + tok * 1024 + 512 + h * 128;
            bf16_t* up = (bf16_t*)(p.ws + WS_H) + tok * 1024 + 512 + h * 128;
#pragma unroll
            for (int dt = 0; dt < 4; ++dt)
#pragma unroll
                for (int g = 0; g < 4; ++g) {
                    const int d0 = 32 * dt + 8 * g + 4 * hh;
                    const u32x2 gg = *(const u32x2*)(gp + d0);
                    const f32x4 sg = *(const f32x4*)(p.subln_g + d0);
                    const float g0 = __uint_as_float(gg.x << 16), g1 = __uint_as_float(gg.x & 0xffff0000u), g2 = __uint_as_float(gg.y << 16), g3 = __uint_as_float(gg.y & 0xffff0000u);
                    u32x2 o;
                    o.x = pk2(O[dt][4 * g] * rs * sg.x * g0, O[dt][4 * g + 1] * rs * sg.y * g1);
                    o.y = pk2(O[dt][4 * g + 2] * rs * sg.z * g2, O[dt][4 * g + 3] * rs * sg.w * g3);
                    *(u32x2*)(up + d0) = o;
                }
        }
    }
    __syncthreads();
}

constexpr int AT_PER_X = 8 + 4 + 256 + 256;
DI void attn_item(const Params& p, char* smem, int v, int q, float lam) {
    int kind, smp, b, h, qb;
    if (q < 8) { kind = 0; smp = 1; b = v; h = q; qb = 0; }
    else if (q < 12) { kind = 1; smp = 1; b = v; h = q - 8; qb = 0; }
    else if (q < 268) {
        const int r = q - 12, second = r >> 7; kind = 1; smp = 0; qb = 127 - (r & 127); b = v >> 1;
        h = (v & 1) ? (second ? 1 : 2) : (second ? 0 : 3); }
    else { const int r = q - 268, rr = r & 127, bh = 4 * v + 2 * (r >> 7) + (rr & 1); kind = 0; smp = 0; qb = 63 - (rr >> 1); b = bh >> 3; h = bh & 7; }
    if (kind == 0) fox_item(p, smem, smp, b, h, qb);
    else diff_item(p, smem, smp, b, h, qb, lam);
}

DI void ln_rows(const Params& p, float* y0, int nrows, int lane) {
#pragma unroll 1
    for (int r = 0; r < nrows; r += 2) {
        float* yr = y0 + (size_t)r * 1024;
        f32x4 v[2][4];
#pragma unroll
        for (int a = 0; a < 2; ++a)
#pragma unroll
            for (int q = 0; q < 4; ++q) v[a][q] = *(const f32x4*)(yr + a * 1024 + q * 256 + lane * 4);
        float mu[2], rstd[2];
#pragma unroll
        for (int a = 0; a < 2; ++a) {
            float s = 0.f;
#pragma unroll
            for (int q = 0; q < 4; ++q) s += (v[a][q].x + v[a][q].y) + (v[a][q].z + v[a][q].w);
            mu[a] = wave_sum(s) * (1.f / 1024.f);
            float s2 = 0.f;
#pragma unroll
            for (int q = 0; q < 4; ++q) { v[a][q].x -= mu[a]; v[a][q].y -= mu[a]; v[a][q].z -= mu[a]; v[a][q].w -= mu[a]; s2 += (v[a][q].x * v[a][q].x + v[a][q].y * v[a][q].y) + (v[a][q].z * v[a][q].z + v[a][q].w * v[a][q].w); }
            rstd[a] = rsqrtf(wave_sum(s2) * (1.f / 1024.f) + 1e-5f);
        }
#pragma unroll
        for (int q = 0; q < 4; ++q) {
            const f32x4 gq = *(const f32x4*)(p.ln_g + q * 256 + lane * 4), bq = *(const f32x4*)(p.ln_b + q * 256 + lane * 4);
#pragma unroll
            for (int a = 0; a < 2; ++a) {
                f32x4 o;
                o.x = v[a][q].x * rstd[a] * gq.x + bq.x; o.y = v[a][q].y * rstd[a] * gq.y + bq.y;
                o.z = v[a][q].z * rstd[a] * gq.z + bq.z; o.w = v[a][q].w * rstd[a] * gq.w + bq.w;
                *(f32x4*)(yr + a * 1024 + q * 256 + lane * 4) = o;
            }
        }
    }
}

DI void phase4_tile(const Params& p, int mt, char* smem) {
    int tid_ = threadIdx.x;
    asm volatile("" : "+v"(tid_));
    const int tid = tid_, lane = tid & 63, wave = tid >> 6, l31 = lane & 31, hh = lane >> 5;
    const bf16_t* A = (const bf16_t*)(p.ws + WS_H) + (size_t)mt * 64 * 1024;
    float* y = p.out + (size_t)mt * 64 * 1024;
    const float* gate = (const float*)(p.ws + WS_MOD) + ((mt * 64) >> 13) * 3072 + 2048;
    for (int nc = 0; nc < 4; ++nc) {
        f32x16 acc[2][2];
        gemm_mainloop<64, 256, 1, true>(A, (const bf16_t*)(p.ws + WS_WTOUT) + (size_t)nc * 256 * 1024, smem, acc);
        const int cb = nc * 256 + wave * 64 + 4 * hh;
#pragma unroll
        for (int i = 0; i < 2; ++i) {
            const int rl = i * 32 + l31;
            const float* xr = p.x_p + (size_t)(mt * 64 + rl) * 1024 + cb;
            float* yr = y + (size_t)rl * 1024 + cb;
            f32x4 xv[2][4];
#pragma unroll
            for (int j = 0; j < 2; ++j)
#pragma unroll
                for (int g = 0; g < 4; ++g) xv[j][g] = *(const f32x4*)(xr + j * 32 + 8 * g);
#pragma unroll
            for (int j = 0; j < 2; ++j)
#pragma unroll
                for (int g = 0; g < 4; ++g) {
                    const f32x4 gt = *(const f32x4*)(gate + cb + j * 32 + 8 * g);
                    f32x4 o;
                    o.x = ALPHA * xv[j][g].x + gt.x * acc[i][j][4 * g]; o.y = ALPHA * xv[j][g].y + gt.y * acc[i][j][4 * g + 1];
                    o.z = ALPHA * xv[j][g].z + gt.z * acc[i][j][4 * g + 2]; o.w = ALPHA * xv[j][g].w + gt.w * acc[i][j][4 * g + 3];
                    *(f32x4*)(yr + j * 32 + 8 * g) = o;
                }
        }
    }
    __threadfence_block();
    __syncthreads();
    ln_rows(p, y + (size_t)(wave * 16) * 1024, 16, lane);
    __syncthreads();
}

DI float dot8(u32x4 a, u32x4 b, float acc) {
    acc += __uint_as_float(a.x << 16) * __uint_as_float(b.x << 16); acc += __uint_as_float(a.x & 0xffff0000u) * __uint_as_float(b.x & 0xffff0000u);
    acc += __uint_as_float(a.y << 16) * __uint_as_float(b.y << 16); acc += __uint_as_float(a.y & 0xffff0000u) * __uint_as_float(b.y & 0xffff0000u);
    acc += __uint_as_float(a.z << 16) * __uint_as_float(b.z << 16); acc += __uint_as_float(a.z & 0xffff0000u) * __uint_as_float(b.z & 0xffff0000u);
    acc += __uint_as_float(a.w << 16) * __uint_as_float(b.w << 16); acc += __uint_as_float(a.w & 0xffff0000u) * __uint_as_float(b.w & 0xffff0000u);
    return acc;
}
DI void sample_out_task(const Params& p, int task, int* s_flag) {
    int tid_ = threadIdx.x;
    asm volatile("" : "+v"(tid_));
    const int tid = tid_, lane = tid & 63, wave = tid >> 6;
    const int b8 = task >> 5, cg = task & 31, row = b8 * 16 + (tid >> 4), col = cg * 32 + (tid & 15) * 2;
    const bf16_t* u = (const bf16_t*)(p.ws + WS_H) + (size_t)(MP + row) * 1024;
    const bf16_t* w0 = (const bf16_t*)(p.ws + WS_WTOUT) + (size_t)col * 1024;
    float a0 = 0.f, a1 = 0.f;
#pragma unroll 4
    for (int c = 0; c < 128; ++c) {
        const u32x4 uu = *(const u32x4*)(u + c * 8);
        a0 = dot8(uu, *(const u32x4*)(w0 + c * 8), a0);
        a1 = dot8(uu, *(const u32x4*)(w0 + 1024 + c * 8), a1);
    }
    const float* gate = (const float*)(p.ws + WS_MOD) + (4 + b8) * 3072 + 2048;
    const float* xr = p.x_s + (size_t)row * 1024;
    float* y = p.out + (size_t)(MP + row) * 1024;
    f32x2 o; o.x = ALPHA * xr[col] + gate[col] * a0; o.y = ALPHA * xr[col + 1] + gate[col + 1] * a1;
    *(f32x2*)(y + col) = o;
    asm volatile("s_waitcnt vmcnt(0)" ::: "memory");
    __syncthreads();
    if (tid == 0) {
        __builtin_amdgcn_fence(__ATOMIC_RELEASE, "agent");
        asm volatile("s_waitcnt vmcnt(0)" ::: "memory");
        const int last = (atomicAdd((int*)(p.ws + WS_CTR) + 8 + b8, 1) == 31);
        if (last) { __builtin_amdgcn_fence(__ATOMIC_ACQUIRE, "agent"); asm volatile("s_waitcnt vmcnt(0)" ::: "memory"); }
        *s_flag = last;
    }
    __syncthreads();
    if (*s_flag) {
        ln_rows(p, p.out + (size_t)(MP + b8 * 16 + wave * 4) * 1024, 4, lane);
    }
    __syncthreads();
}

#define XB_XCNT(j) (64 * (j))
#define XB_XSUB(j) (64 * (16 + (j)))
#define XB_XGEN(j) (64 * (32 + (j)))
#define XB_TOP (64 * 48)
#define XB_TOPGEN (64 * 49)
DI unsigned bar_ld(unsigned* p) { return __hip_atomic_load(p, __ATOMIC_RELAXED, __HIP_MEMORY_SCOPE_AGENT); }
DI unsigned bar_add(unsigned* p) { return __hip_atomic_fetch_add(p, 1u, __ATOMIC_RELAXED, __HIP_MEMORY_SCOPE_AGENT); }
DI unsigned xcc_id() { return (unsigned)__builtin_amdgcn_s_getreg((3 << 11) | 20) & 0xFu; }
DI void grid_barrier(unsigned* bar, volatile unsigned* st  ) {
    asm volatile("s_waitcnt vmcnt(0)" ::: "memory");
    __syncthreads();
    if (threadIdx.x == 0) {
        __builtin_amdgcn_s_waitcnt(0);
        const unsigned x = xcc_id();
        unsigned nloc = st[0], nx = st[1];
        if (nloc == 0u) {
            const unsigned G = gridDim.x;
            unsigned sum, cnt, mine, sp = 0u;
            for (;;) {
                sum = 0u; cnt = 0u; mine = 0u;
#pragma unroll
                for (unsigned j = 0; j < 16; ++j) { const unsigned c = bar_ld(&bar[XB_XCNT(j)]); sum += c; cnt += (c > 0u) ? 1u : 0u; mine = (j == x) ? c : mine; }
                if (sum == G || ++sp > (1u << 22)) break;
                __builtin_amdgcn_s_sleep(1);
            }
            nloc = mine > 0u ? mine : 1u; nx = cnt > 0u ? cnt : 1u;
            st[0] = nloc; st[1] = nx;
        }
        const unsigned old = bar_add(&bar[XB_XSUB(x)]);
        const unsigned gen = old / nloc;
        unsigned sp = 0u;
        if (old + 1u == (gen + 1u) * nloc) {
            __builtin_amdgcn_fence(__ATOMIC_RELEASE, "agent");
            asm volatile("s_waitcnt vmcnt(0)" ::: "memory");
            const unsigned og = bar_add(&bar[XB_TOP]);
            const unsigned tg = og / nx;
            if (og + 1u == (tg + 1u) * nx) bar_add(&bar[XB_TOPGEN]);
            else while (bar_ld(&bar[XB_TOPGEN]) == tg && ++sp < (1u << 24)) __builtin_amdgcn_s_sleep(1);
            __builtin_amdgcn_fence(__ATOMIC_ACQUIRE, "agent");
            bar_add(&bar[XB_XGEN(x)]);
            asm volatile("s_waitcnt vmcnt(0)" ::: "memory");
        } else {
            while (bar_ld(&bar[XB_XGEN(x)]) == gen && ++sp < (1u << 24)) __builtin_amdgcn_s_sleep(1);
            __builtin_amdgcn_fence(__ATOMIC_ACQUIRE, "agent");
            asm volatile("s_waitcnt vmcnt(0)" ::: "memory");
        }
    }
    __syncthreads();
}

template <int MODE>
__global__ void __launch_bounds__(NTHREADS, 2) mega(Params p) {
    __shared__ __attribute__((aligned(16))) char smem[SMEM_BYTES];
    __shared__ int s_item;
    __shared__ unsigned s_bar[4];
    const int tid = threadIdx.x, nblk = gridDim.x, bid = blockIdx.x;
    unsigned* bar = (unsigned*)(p.ws + WS_BAR);
    if constexpr (MODE < 0) {
        if (tid == 0) { s_bar[0] = 0u; s_bar[1] = 0u; bar_add(&bar[XB_XCNT(xcc_id())]); }
    }
    if constexpr (MODE < 0) {
        if (p.ws == nullptr) cg::this_grid().sync();
    }
    if (MODE < 0 || MODE == 0) {
        if (bid == 0 && tid < 16) ((int*)(p.ws + WS_CTR))[tid] = 0;
        if (bid == 0 && tid == 0) {
            const float** st = (const float**)(p.ws + WS_CTR + 128);
            st[0] = p.x_p; st[1] = p.x_s; st[2] = p.ln_g; st[3] = p.ln_b;
        }
        for (int it = bid; it < P0_TOTAL; it += nblk) phase0_item(p, it, smem);
    }
    if constexpr (MODE < 0) grid_barrier(bar, s_bar);
    if (MODE < 0 || MODE == 1) {
        for (int it = bid; it < MT / 16; it += nblk) phase1_item(p, it);
    }
    if constexpr (MODE < 0) grid_barrier(bar, s_bar);
    if (MODE < 0 || MODE == 2) {
        const int v = bid & 7, nbx = (nblk - v + 7) >> 3;
        for (int q = bid >> 3; q < P2_PER_X; q += nbx) {
            int mt, nt;
            const int kind = phase2_decode(v, q, mt, nt);
            if (kind == 1) phase2_tile_w(p, mt, nt, smem);
            else if (kind == 2) phase2_tile(p, mt, nt, smem);
        }
    }
    if constexpr (MODE < 0) grid_barrier(bar, s_bar);
    if (MODE < 0 || MODE == 3) {
        const int lane = tid & 63;
        const float d1 = wave_sum(p.lq1[lane] * p.lk1[lane]), d2 = wave_sum(p.lq2[lane] * p.lk2[lane]);
        const float lam = __expf(d1) - __expf(d2) + 0.2f;
        for (int k = 0; k < 8; ++k) {
            const int v = (bid + k) & 7;
            for (;;) {
                if (tid == 0) s_item = atomicAdd((int*)(p.ws + WS_CTR) + v, 1);
                __syncthreads();
                const int q = s_item;
                __syncthreads();
                if (q >= AT_PER_X) break;
                attn_item(p, smem, v, q, lam);
            }
        }
    }
    if constexpr (MODE < 0) grid_barrier(bar, s_bar);
    if (MODE < 0 || MODE == 4) {
        Params p4;
        p4.out = p.out; p4.ws = p.ws;
        asm volatile("" : "+s"(p4.out), "+s"(p4.ws));
        if constexpr (MODE < 0) {
            const float* const* st = (const float* const*)(p.ws + WS_CTR + 128);
            p4.x_p = __builtin_nontemporal_load(st + 0); p4.x_s = __builtin_nontemporal_load(st + 1);
            p4.ln_g = __builtin_nontemporal_load(st + 2); p4.ln_b = __builtin_nontemporal_load(st + 3);
        } else { p4.x_p = p.x_p; p4.x_s = p.x_s; p4.ln_g = p.ln_g; p4.ln_b = p.ln_b; }
        for (int t = bid; t < 256; t += nblk) sample_out_task(p4, t, &s_item);
        for (int t = bid; t < MP / 64; t += nblk) phase4_tile(p4, t, smem);
    }
}

extern "C" void kernel_launch(void* const* d_in, const int* in_sizes, int n_in, void* d_out, int out_size, void* d_ws, size_t ws_size, hipStream_t stream) {
    static int grid = 0;
    if (grid == 0) {
        if (n_in != 21 || ws_size < WS_END) { fprintf(stderr, "kernel_launch: unexpected n_in %d / ws_size %zu (need %zu)\n", n_in, ws_size, (size_t)WS_END); grid = -1; return; }
        int dev = 0, cus = 0, per_cu = 0;
        hipGetDevice(&dev);
        hipDeviceGetAttribute(&cus, hipDeviceAttributeMultiprocessorCount, dev);
#if FUSED
        hipOccupancyMaxActiveBlocksPerMultiprocessor(&per_cu, mega<-1>, NTHREADS, 0);
#else
        per_cu = 2;
#endif
        if (per_cu < 1) { fprintf(stderr, "kernel_launch: occupancy query says %d blocks per CU\n", per_cu); grid = -1; return; }
        if (per_cu > 2) per_cu = 2;
        grid = cus * per_cu;
    }
    if (grid < 0) return;
    Params p{};
    p.x_p = (const float*)d_in[0]; p.x_s = (const float*)d_in[1]; p.ck_f = (const float*)d_in[2]; p.cv_f = (const float*)d_in[3]; p.clogf = (const float*)d_in[4];
    p.ck_d = (const float*)d_in[5]; p.cv_d = (const float*)d_in[6]; p.c_p = (const float*)d_in[7]; p.c_s = (const float*)d_in[8]; p.w_ada = (const float*)d_in[9];
    p.b_ada = (const float*)d_in[10]; p.w_in = (const float*)d_in[11]; p.b_f = (const float*)d_in[12]; p.lq1 = (const float*)d_in[13]; p.lk1 = (const float*)d_in[14];
    p.lq2 = (const float*)d_in[15]; p.lk2 = (const float*)d_in[16]; p.subln_g = (const float*)d_in[17]; p.w_out = (const float*)d_in[18]; p.ln_g = (const float*)d_in[19];
    p.ln_b = (const float*)d_in[20]; p.out = (float*)d_out; p.ws = (char*)d_ws;
    hipMemsetAsync((char*)d_ws + WS_BAR, 0, 64 * 256 + 1024, stream);
#if FUSED
    void* args[] = {&p};
    hipError_t e = hipLaunchCooperativeKernel((void*)mega<-1>, dim3(grid), dim3(NTHREADS), args, 0, stream);
    if (e != hipSuccess) fprintf(stderr, "cooperative launch failed: %s (grid %d)\n", hipGetErrorString(e), grid);
#else
    for (int r = 0; r < L0_REPS; ++r) mega<0><<<grid, NTHREADS, 0, stream>>>(p);
    for (int r = 0; r < L1_REPS; ++r) mega<1><<<grid, NTHREADS, 0, stream>>>(p);
    for (int r = 0; r < L2_REPS; ++r) mega<2><<<grid, NTHREADS, 0, stream>>>(p);
    mega<3><<<grid, NTHREADS, 0, stream>>>(p);
    for (int r = 0; r < L4_REPS; ++r) mega<4><<<grid, NTHREADS, 0, stream>>>(p);
#endif
}
```

```cpp
#include <hip/hip_runtime.h>
#include <hip/hip_cooperative_groups.h>
#include <cstdio>
#include <cstdint>
#include <type_traits>
namespace cg = cooperative_groups;

#ifndef FUSED
#define FUSED 1
#endif

#ifndef L0_REPS
#define L0_REPS 1
#endif
#ifndef L1_REPS
#define L1_REPS 1
#endif
#ifndef L2_REPS
#define L2_REPS 1
#endif
#ifndef L4_REPS
#define L4_REPS 1
#endif
#ifndef ATTN_REPS
#define ATTN_REPS 1
#endif
#ifndef P0_REPS
#define P0_REPS 1
#endif
#ifndef P1_REPS
#define P1_REPS 1
#endif
#ifndef P2_REPS
#define P2_REPS 1
#endif
#ifndef P4_REPS
#define P4_REPS 1
#endif
#define DI __device__ __forceinline__
typedef unsigned short bf16_t;
typedef short bf16x8 __attribute__((ext_vector_type(8)));
typedef short s16x4 __attribute__((ext_vector_type(4)));
typedef float f32x16 __attribute__((ext_vector_type(16)));
typedef float f32x4 __attribute__((ext_vector_type(4)));
typedef float f32x2 __attribute__((ext_vector_type(2)));
typedef unsigned u32x4 __attribute__((ext_vector_type(4)));
typedef unsigned u32x2 __attribute__((ext_vector_type(2)));
typedef __bf16 bf2_t __attribute__((ext_vector_type(2)));
#define MFMA32(a, b, c) __builtin_amdgcn_mfma_f32_32x32x16_bf16((a), (b), (c), 0, 0, 0)

constexpr int DM = 1024, SEQ = 8192, NB = 4, SB = 8, ST = 16, PAST = 2048;
constexpr int MP = NB * SEQ, MS = SB * ST, MT = MP + MS;
constexpr int SKV = 2112;
constexpr int NWT = 4224;
constexpr float LOG2E = 1.4426950408889634f;
constexpr float QSCALE = 0.125f * LOG2E;
constexpr float ALPHA = 1.189207115002721f;
constexpr int NTHREADS = 256;
constexpr int SMEM_BYTES = 73728;
#ifndef FAST_B2_MAX
#define FAST_B2_MAX 60.f
#endif

constexpr size_t OFF_YP = 0, OFF_YS = 33554432, OFF_PKF = 33685504, OFF_PVF = 50462720, OFF_PLOGF = 67239936, OFF_PKD = 67502080,
                 OFF_PVD = 84279296, OFF_SKF = 101056512, OFF_SVF = 101122048, OFF_SLOGF = 101187584, OFF_SKD = 101188608, OFF_SVD = 101254144;

constexpr size_t al256(size_t x) { return (x + 255) & ~(size_t)255; }
constexpr size_t WS_CTR = 0;
constexpr size_t WS_MOD = 256;
constexpr size_t WS_WTIN = al256(WS_MOD + 12 * 3072 * 4);
constexpr size_t WS_WTOUT = al256(WS_WTIN + (size_t)NWT * 1024 * 2);
constexpr size_t WS_H = al256(WS_WTOUT + (size_t)1024 * 1024 * 2);
constexpr size_t WS_G = al256(WS_H + (size_t)MT * 1024 * 2);
constexpr size_t WS_QF = al256(WS_G + (size_t)MT * 1024 * 2);
constexpr size_t WS_QFS = WS_QF + (size_t)32 * 8192 * 64 * 2;
constexpr size_t WS_KF = al256(WS_QFS + (size_t)64 * 16 * 64 * 2);
constexpr size_t WS_KFS = WS_KF + (size_t)32 * 8192 * 64 * 2;
constexpr size_t WS_VFT = al256(WS_KFS + (size_t)64 * SKV * 64 * 2);
constexpr size_t WS_VFTS = WS_VFT + (size_t)32 * 64 * 8192 * 2;
constexpr size_t WS_LFS = al256(WS_VFTS + (size_t)64 * 64 * SKV * 2);
constexpr size_t WS_QD = al256(WS_LFS + (size_t)64 * SKV * 4);
constexpr size_t WS_QDS = WS_QD + (size_t)16 * 8192 * 128 * 2;
constexpr size_t WS_KD = al256(WS_QDS + (size_t)32 * 16 * 128 * 2);
constexpr size_t WS_KDS = WS_KD + (size_t)16 * 8192 * 128 * 2;
constexpr size_t WS_VDT = al256(WS_KDS + (size_t)32 * SKV * 128 * 2);
constexpr size_t WS_VDTS = WS_VDT + (size_t)16 * 128 * 8192 * 2;
constexpr size_t WS_BAR = al256(WS_VDTS + (size_t)32 * 128 * SKV * 2);
constexpr size_t WS_NRM = WS_BAR + 64 * 256;
constexpr int NRM_FP = 0, NRM_FS = 32, NRM_DP = 96, NRM_DS = 128, NRM_WORDS = 192;
constexpr size_t WS_END = WS_NRM + 1024;

struct Params {
    const float *x_p, *x_s, *ck_f, *cv_f, *clogf, *ck_d, *cv_d, *c_p, *c_s, *w_ada, *b_ada, *w_in, *b_f, *lq1, *lk1, *lq2, *lk2, *subln_g, *w_out, *ln_g, *ln_b;
    float* out;
    char* ws;
};

DI unsigned pk2(float a, float b) { f32x2 v; v.x = a; v.y = b; bf2_t r = __builtin_convertvector(v, bf2_t); return __builtin_bit_cast(unsigned, r); }
DI bf16_t cvt1(float a) { return (bf16_t)(pk2(a, 0.f) & 0xffffu); }
DI float bf2f(unsigned short u) { return __uint_as_float(((unsigned)u) << 16); }
DI float siluf(float v) { return v * __builtin_amdgcn_rcpf(1.f + __builtin_amdgcn_exp2f(-1.4426950408889634f * v)); }
DI float wave_sum(float v) { for (int o = 32; o > 0; o >>= 1) v += __shfl_xor(v, o); return v; }
DI float ex2(float x) { return __builtin_amdgcn_exp2f(x); }

DI float max16(float v) { v = fmaxf(v, __shfl_xor(v, 8)); v = fmaxf(v, __shfl_xor(v, 4)); v = fmaxf(v, __shfl_xor(v, 2)); v = fmaxf(v, __shfl_xor(v, 1)); return v; }
DI void nrm_max(const Params& p, int idx, float v) { atomicMax((unsigned*)(p.ws + WS_NRM) + idx, __float_as_uint(v)); }
DI float sq8(u32x4 a) {
    float s = 0.f, t;
    t = __uint_as_float(a.x << 16); s += t * t; t = __uint_as_float(a.x & 0xffff0000u); s += t * t;
    t = __uint_as_float(a.y << 16); s += t * t; t = __uint_as_float(a.y & 0xffff0000u); s += t * t;
    t = __uint_as_float(a.z << 16); s += t * t; t = __uint_as_float(a.z & 0xffff0000u); s += t * t;
    t = __uint_as_float(a.w << 16); s += t * t; t = __uint_as_float(a.w & 0xffff0000u); s += t * t;
    return s;
}

DI void transpose_tile(const float* __restrict__ src, int ld_src, int ncv, bf16_t* __restrict__ dst, int ld_dst, char* smem) {
    float* t = (float*)smem;
    const int tid = threadIdx.x, tr = tid >> 4, tc = (tid & 15) * 4;
#pragma unroll
    for (int q = 0; q < 4; ++q) {
        const int r = tr + 16 * q;
        f32x4 v = {0.f, 0.f, 0.f, 0.f};
        if (tc < ncv) v = *(const f32x4*)(src + (size_t)r * ld_src + tc);
        t[r * 65 + tc] = v.x; t[r * 65 + tc + 1] = v.y; t[r * 65 + tc + 2] = v.z; t[r * 65 + tc + 3] = v.w;
    }
    __syncthreads();
#pragma unroll
    for (int q = 0; q < 2; ++q) {
        const int ch = tid + 256 * q, c = ch >> 3, rc = (ch & 7) * 8;
        u32x4 o;
        o.x = pk2(t[(rc + 0) * 65 + c], t[(rc + 1) * 65 + c]);
        o.y = pk2(t[(rc + 2) * 65 + c], t[(rc + 3) * 65 + c]);
        o.z = pk2(t[(rc + 4) * 65 + c], t[(rc + 5) * 65 + c]);
        o.w = pk2(t[(rc + 6) * 65 + c], t[(rc + 7) * 65 + c]);
        *(u32x4*)(dst + (size_t)c * ld_dst + rc) = o;
    }
    __syncthreads();
}

constexpr int P0_ADA = 192, P0_WIN = 66 * 16, P0_WOUT = 256, P0_CKF = 2048, P0_CVF = 2048, P0_CLF = 64, P0_CKD = 2048, P0_CVD = 2048;
constexpr int P0_TOTAL = P0_ADA + P0_WIN + P0_WOUT + P0_CKF + P0_CVF + P0_CLF + P0_CKD + P0_CVD;

DI void phase0_item(const Params& p, int it, char* smem) {
    const int tid = threadIdx.x;
    if (it < P0_ADA) {
        float* sc = (float*)smem;
        float* red = (float*)(smem + 49152);
        for (int i = tid; i < 12 * 1024; i += NTHREADS) {
            const int r = i >> 10, k = i & 1023;
            const float c = (r < 4) ? p.c_p[r * 1024 + k] : p.c_s[(r - 4) * 1024 + k];
            sc[i] = siluf(c);
        }
        __syncthreads();
        const int n0 = it * 16, col = tid & 15, kg = tid >> 4;
        float acc[12];
#pragma unroll
        for (int r = 0; r < 12; ++r) acc[r] = 0.f;
#pragma unroll 4
        for (int kk = 0; kk < 64; ++kk) {
            const int k = kg * 64 + kk;
            const float w = p.w_ada[(size_t)k * 3072 + n0 + col];
#pragma unroll
            for (int r = 0; r < 12; ++r) acc[r] += sc[r * 1024 + k] * w;
        }
#pragma unroll
        for (int r = 0; r < 12; ++r) red[(kg * 12 + r) * 16 + col] = acc[r];
        __syncthreads();
        if (tid < 192) {
            const int r = tid >> 4, c2 = tid & 15;
            float s = p.b_ada[n0 + c2];
#pragma unroll
            for (int g = 0; g < 16; ++g) s += red[(g * 12 + r) * 16 + c2];
            ((float*)(p.ws + WS_MOD))[r * 3072 + n0 + c2] = s;
        }
        __syncthreads();
        return;
    }
    it -= P0_ADA;
    if (it < P0_WIN) {
        const int rg = it >> 4, kg = it & 15;
        const int n0 = rg * 64;
        int src_c, ncv = 64;
        if (n0 < 4096) {
            const int seg = n0 >> 9, off = n0 & 511;
            const int segbase = (seg == 0) ? 0 : (seg == 1) ? 512 : (seg == 2) ? 1024 : (seg == 3) ? 1544 : (seg == 4) ? 2056 : (seg == 5) ? 2568 : (seg == 6) ? 3080 : 3592;
            src_c = segbase + off;
        } else if (n0 == 4096) { src_c = 1536; ncv = 8; }
        else { src_c = 1536; ncv = 0; }
        transpose_tile(p.w_in + (size_t)(kg * 64) * 4104 + src_c, 4104, ncv, (bf16_t*)(p.ws + WS_WTIN) + (size_t)n0 * 1024 + kg * 64, 1024, smem);
        return;
    }
    it -= P0_WIN;
    if (it < P0_WOUT) {
        const int rg = it >> 4, kg = it & 15;
        transpose_tile(p.w_out + (size_t)(kg * 64) * 1024 + rg * 64, 1024, 64, (bf16_t*)(p.ws + WS_WTOUT) + (size_t)(rg * 64) * 1024 + kg * 64, 1024, smem);
        return;
    }
    it -= P0_WOUT;
    if (it < P0_CKF) {
        const int bh = it >> 5, r0 = (it & 31) * 64;
        const float* s = p.ck_f + ((size_t)bh * 2048 + r0) * 64;
        bf16_t* d = (bf16_t*)(p.ws + WS_KFS) + ((size_t)bh * SKV + r0) * 64;
        float nm = 0.f;
#pragma unroll
        for (int q = 0; q < 2; ++q) {
            const int e = (tid + 256 * q) * 8;
            const f32x4 a = *(const f32x4*)(s + e), b = *(const f32x4*)(s + e + 4);
            u32x4 o; o.x = pk2(a.x, a.y); o.y = pk2(a.z, a.w); o.z = pk2(b.x, b.y); o.w = pk2(b.z, b.w);
            *(u32x4*)(d + e) = o;
            float ss = (a.x * a.x + a.y * a.y) + (a.z * a.z + a.w * a.w) + (b.x * b.x + b.y * b.y) + (b.z * b.z + b.w * b.w);
            ss += __shfl_xor(ss, 1); ss += __shfl_xor(ss, 2); ss += __shfl_xor(ss, 4);
            nm = fmaxf(nm, ss);
        }
        nm = fmaxf(nm, __shfl_xor(nm, 8)); nm = fmaxf(nm, __shfl_xor(nm, 16)); nm = fmaxf(nm, __shfl_xor(nm, 32));
        if ((tid & 63) == 0) nrm_max(p, NRM_FS + bh, nm);
        return;
    }
    it -= P0_CKF;
    if (it < P0_CVF) {
        const int bh = it >> 5, r0 = (it & 31) * 64;
        transpose_tile(p.cv_f + ((size_t)bh * 2048 + r0) * 64, 64, 64, (bf16_t*)(p.ws + WS_VFTS) + (size_t)bh * 64 * SKV + r0, SKV, smem);
        return;
    }
    it -= P0_CVF;
    if (it < P0_CLF) {
        const float* s = p.clogf + (size_t)it * 2048;
        float* d = (float*)(p.ws + WS_LFS) + (size_t)it * SKV;
#pragma unroll
        for (int q = 0; q < 2; ++q) { const int e = (tid + 256 * q) * 4; *(f32x4*)(d + e) = *(const f32x4*)(s + e); }
        {
            const u32x4 z = {0u, 0u, 0u, 0u};
            bf16_t* vf = (bf16_t*)(p.ws + WS_VFTS) + (size_t)it * 64 * SKV;
            bf16_t* vd = (bf16_t*)(p.ws + WS_VDTS) + ((size_t)(it >> 1) * 128 + (it & 1) * 64) * SKV;
            for (int e = tid; e < 64 * 6; e += NTHREADS) {
                const int r = e / 6, c = e % 6;
                *(u32x4*)(vf + (size_t)r * SKV + 2064 + c * 8) = z;
                *(u32x4*)(vd + (size_t)r * SKV + 2064 + c * 8) = z;
            }
        }
        return;
    }
    it -= P0_CLF;
    if (it < P0_CKD) {
        const int bh = it >> 6, r0 = (it & 63) * 32;
        const float* s = p.ck_d + ((size_t)bh * 2048 + r0) * 128;
        bf16_t* d = (bf16_t*)(p.ws + WS_KDS) + ((size_t)bh * SKV + r0) * 128;
        float nm = 0.f;
#pragma unroll
        for (int q = 0; q < 2; ++q) {
            const int e = (tid + 256 * q) * 8;
            const f32x4 a = *(const f32x4*)(s + e), b = *(const f32x4*)(s + e + 4);
            u32x4 o; o.x = pk2(a.x, a.y); o.y = pk2(a.z, a.w); o.z = pk2(b.x, b.y); o.w = pk2(b.z, b.w);
            *(u32x4*)(d + e) = o;
            float ss = (a.x * a.x + a.y * a.y) + (a.z * a.z + a.w * a.w) + (b.x * b.x + b.y * b.y) + (b.z * b.z + b.w * b.w);
            ss += __shfl_xor(ss, 1); ss += __shfl_xor(ss, 2); ss += __shfl_xor(ss, 4);
            nm = fmaxf(nm, ss);
        }
        nm = fmaxf(nm, __shfl_xor(nm, 16)); nm = fmaxf(nm, __shfl_xor(nm, 32));
        if ((tid & 55) == 0) nrm_max(p, NRM_DS + bh * 2 + ((tid >> 3) & 1), nm);
        return;
    }
    it -= P0_CKD;
    {
        const int bh = it >> 6, rem = it & 63, r0 = (rem >> 1) * 64, dh = rem & 1;
        transpose_tile(p.cv_d + ((size_t)bh * 2048 + r0) * 128 + dh * 64, 128, 64, (bf16_t*)(p.ws + WS_VDTS) + ((size_t)bh * 128 + dh * 64) * SKV + r0, SKV, smem);
    }
}

DI void phase1_item(const Params& p, int it) {
    const int tid = threadIdx.x, tok0 = it * 16;
    const float* x; int r12;
    if (tok0 < MP) { x = p.x_p + (size_t)tok0 * 1024; r12 = tok0 >> 13; }
    else { x = p.x_s + (size_t)(tok0 - MP) * 1024; r12 = 4 + ((tok0 - MP) >> 4); }
    const float* mod = (const float*)(p.ws + WS_MOD) + r12 * 3072;
    const f32x4 sh = *(const f32x4*)(mod + tid * 4), sc = *(const f32x4*)(mod + 1024 + tid * 4);
    bf16_t* h = (bf16_t*)(p.ws + WS_H) + (size_t)tok0 * 1024;
#pragma unroll
    for (int r0 = 0; r0 < 16; r0 += 8) {
        f32x4 v[8];
#pragma unroll
        for (int r = 0; r < 8; ++r) v[r] = *(const f32x4*)(x + (r0 + r) * 1024 + tid * 4);
#pragma unroll
        for (int r = 0; r < 8; ++r) {
            u32x2 o;
            o.x = pk2(v[r].x * (1.f + sc.x) + sh.x, v[r].y * (1.f + sc.y) + sh.y);
            o.y = pk2(v[r].z * (1.f + sc.z) + sh.z, v[r].w * (1.f + sc.w) + sh.w);
            *(u32x2*)(h + (r0 + r) * 1024 + tid * 4) = o;
        }
    }
}

template <int BM, int BN, int WGM, bool SWAP>
DI void gemm_mainloop(const bf16_t* __restrict__ A, const bf16_t* __restrict__ B, char* smem, f32x16 (&acc)[2][2]) {
    constexpr int NA = BM / 32, NBC = BN / 32, LDR = 144;
    const int tid = threadIdx.x, lane = tid & 63, wave = tid >> 6, l31 = lane & 31, hh = lane >> 5;
    const int wm = wave % WGM, wn = wave / WGM;
    char* sA = smem; char* sB = smem + BM * LDR;
    u32x4 ra[NA], rb[NBC];
    const int crow_ = tid >> 3, ck = (tid & 7) * 8;
#pragma unroll
    for (int c = 0; c < NA; ++c) ra[c] = *(const u32x4*)(A + (size_t)(crow_ + 32 * c) * 1024 + ck);
#pragma unroll
    for (int c = 0; c < NBC; ++c) rb[c] = *(const u32x4*)(B + (size_t)(crow_ + 32 * c) * 1024 + ck);
#pragma unroll
    for (int i = 0; i < 2; ++i)
#pragma unroll
        for (int j = 0; j < 2; ++j)
#pragma unroll
            for (int r = 0; r < 16; ++r) acc[i][j][r] = 0.f;
    const int aoff = (wm * 64 + l31) * LDR + hh * 16, boff = (wn * 64 + l31) * LDR + hh * 16;
    for (int k0 = 0; k0 < 1024; k0 += 64) {
        __syncthreads();
#pragma unroll
        for (int c = 0; c < NA; ++c) *(u32x4*)(sA + (crow_ + 32 * c) * LDR + ck * 2) = ra[c];
#pragma unroll
        for (int c = 0; c < NBC; ++c) *(u32x4*)(sB + (crow_ + 32 * c) * LDR + ck * 2) = rb[c];
        __syncthreads();
        if (k0 + 64 < 1024) {
#pragma unroll
            for (int c = 0; c < NA; ++c) ra[c] = *(const u32x4*)(A + (size_t)(crow_ + 32 * c) * 1024 + k0 + 64 + ck);
#pragma unroll
            for (int c = 0; c < NBC; ++c) rb[c] = *(const u32x4*)(B + (size_t)(crow_ + 32 * c) * 1024 + k0 + 64 + ck);
        }
#pragma unroll
        for (int s = 0; s < 4; ++s) {
            bf16x8 a0 = *(const bf16x8*)(sA + aoff + s * 32), a1 = *(const bf16x8*)(sA + aoff + 32 * LDR + s * 32);
            bf16x8 b0 = *(const bf16x8*)(sB + boff + s * 32), b1 = *(const bf16x8*)(sB + boff + 32 * LDR + s * 32);
            if constexpr (SWAP) {
                acc[0][0] = MFMA32(b0, a0, acc[0][0]);
                acc[0][1] = MFMA32(b1, a0, acc[0][1]);
                acc[1][0] = MFMA32(b0, a1, acc[1][0]);
                acc[1][1] = MFMA32(b1, a1, acc[1][1]);
            } else {
                acc[0][0] = MFMA32(a0, b0, acc[0][0]);
                acc[0][1] = MFMA32(a0, b1, acc[0][1]);
                acc[1][0] = MFMA32(a1, b0, acc[1][0]);
                acc[1][1] = MFMA32(a1, b1, acc[1][1]);
            }
        }
    }
}

template <bool SWAP>
DI void gemm_mainloop_db(const bf16_t* __restrict__ A, const bf16_t* __restrict__ B, char* smem, f32x16 (&acc)[2][2]) {
    constexpr int LDR = 144, STAGE = 256 * LDR;
    const int tid = threadIdx.x, lane = tid & 63, wave = tid >> 6, l31 = lane & 31, hh = lane >> 5;
    const int wm = wave & 1, wn = wave >> 1;
    u32x4 ra[4], rb[4];
    const int crow_ = tid >> 3, ck = (tid & 7) * 8;
    const bf16_t* Ap = A + (size_t)crow_ * 1024 + ck;
    const bf16_t* Bp = B + (size_t)crow_ * 1024 + ck;
    const int woff = crow_ * LDR + ck * 2;
#pragma unroll
    for (int c = 0; c < 4; ++c) { ra[c] = *(const u32x4*)(Ap + (size_t)(32 * c) * 1024); rb[c] = *(const u32x4*)(Bp + (size_t)(32 * c) * 1024); }
#pragma unroll
    for (int i = 0; i < 2; ++i)
#pragma unroll
        for (int j = 0; j < 2; ++j)
#pragma unroll
            for (int r = 0; r < 16; ++r) acc[i][j][r] = 0.f;
#pragma unroll
    for (int c = 0; c < 4; ++c) { *(u32x4*)(smem + woff + 32 * c * LDR) = ra[c]; *(u32x4*)(smem + 128 * LDR + woff + 32 * c * LDR) = rb[c]; }
#pragma unroll
    for (int c = 0; c < 4; ++c) { ra[c] = *(const u32x4*)(Ap + (size_t)(32 * c) * 1024 + 64); rb[c] = *(const u32x4*)(Bp + (size_t)(32 * c) * 1024 + 64); }
    __syncthreads();
    const int aoff = (wm * 64 + l31) * LDR + hh * 16, boff = 128 * LDR + (wn * 64 + l31) * LDR + hh * 16;
#pragma unroll 1
    for (int kt = 0; kt < 16; ++kt) {
        const char* sb = smem + (kt & 1) * STAGE;
#pragma unroll
        for (int s = 0; s < 4; ++s) {
            bf16x8 a0 = *(const bf16x8*)(sb + aoff + s * 32), a1 = *(const bf16x8*)(sb + aoff + 32 * LDR + s * 32);
            bf16x8 b0 = *(const bf16x8*)(sb + boff + s * 32), b1 = *(const bf16x8*)(sb + boff + 32 * LDR + s * 32);
            if constexpr (SWAP) {
                acc[0][0] = MFMA32(b0, a0, acc[0][0]);
                acc[0][1] = MFMA32(b1, a0, acc[0][1]);
                acc[1][0] = MFMA32(b0, a1, acc[1][0]);
                acc[1][1] = MFMA32(b1, a1, acc[1][1]);
            } else {
                acc[0][0] = MFMA32(a0, b0, acc[0][0]);
                acc[0][1] = MFMA32(a0, b1, acc[0][1]);
                acc[1][0] = MFMA32(a1, b0, acc[1][0]);
                acc[1][1] = MFMA32(a1, b1, acc[1][1]);
            }
        }
        if (kt + 1 < 16) {
            char* sw = smem + ((kt + 1) & 1) * STAGE;
#pragma unroll
            for (int c = 0; c < 4; ++c) { *(u32x4*)(sw + woff + 32 * c * LDR) = ra[c]; *(u32x4*)(sw + 128 * LDR + woff + 32 * c * LDR) = rb[c]; }
            if (kt + 2 < 16) {
#pragma unroll
                for (int c = 0; c < 4; ++c) { ra[c] = *(const u32x4*)(Ap + (size_t)(32 * c) * 1024 + (kt + 2) * 64); rb[c] = *(const u32x4*)(Bp + (size_t)(32 * c) * 1024 + (kt + 2) * 64); }
            }
        }
        __syncthreads();
    }
}

DI float logsigmoidf(float x) { return fminf(x, 0.f) - log1pf(__expf(-fabsf(x))); }

DI u32x2 pk4(float a, float b, float c, float d) { u32x2 r; r.x = pk2(a, b); r.y = pk2(c, d); return r; }
DI u32x4 widen_pair(u32x2 a, u32x2 b) {
    auto r0 = __builtin_amdgcn_permlane32_swap(a.x, b.x, false, false);
    auto r1 = __builtin_amdgcn_permlane32_swap(a.y, b.y, false, false);
    u32x4 o; o.x = r0[0]; o.y = r1[0]; o.z = r0[1]; o.w = r1[1];
    return o;
}
template <bool SWAP>
DI void gemm_mainloop_w(const bf16_t* __restrict__ A, const bf16_t* __restrict__ B, char* smem, f32x16 (&acc)[2][4]) {
    constexpr int LDR = 80, STAGE = 384 * LDR;
    const int tid = threadIdx.x, lane = tid & 63, wave = tid >> 6, l31 = lane & 31, hh = lane >> 5;
    const int wm = wave & 1, wn = wave >> 1;
    u32x4 ra[2], rb[4];
    const int crow_ = tid >> 2, ck = (tid & 3) * 8;
    const bf16_t* Ap = A + (size_t)crow_ * 1024 + ck;
    const bf16_t* Bp = B + (size_t)crow_ * 1024 + ck;
    const int woff = crow_ * LDR + ck * 2;
#pragma unroll
    for (int c = 0; c < 2; ++c) ra[c] = *(const u32x4*)(Ap + (size_t)(64 * c) * 1024);
#pragma unroll
    for (int c = 0; c < 4; ++c) rb[c] = *(const u32x4*)(Bp + (size_t)(64 * c) * 1024);
#pragma unroll
    for (int i = 0; i < 2; ++i)
#pragma unroll
        for (int j = 0; j < 4; ++j)
#pragma unroll
            for (int r = 0; r < 16; ++r) acc[i][j][r] = 0.f;
#pragma unroll
    for (int c = 0; c < 2; ++c) *(u32x4*)(smem + woff + 64 * c * LDR) = ra[c];
#pragma unroll
    for (int c = 0; c < 4; ++c) *(u32x4*)(smem + 128 * LDR + woff + 64 * c * LDR) = rb[c];
#pragma unroll
    for (int c = 0; c < 2; ++c) ra[c] = *(const u32x4*)(Ap + (size_t)(64 * c) * 1024 + 32);
#pragma unroll
    for (int c = 0; c < 4; ++c) rb[c] = *(const u32x4*)(Bp + (size_t)(64 * c) * 1024 + 32);
    __syncthreads();
    const int aoff = (wm * 64 + l31) * LDR + hh * 16, boff = 128 * LDR + (wn * 128 + l31) * LDR + hh * 16;
#pragma unroll 1
    for (int kt = 0; kt < 32; ++kt) {
        const char* sb = smem + (kt & 1) * STAGE;
#pragma unroll
        for (int s = 0; s < 2; ++s) {
            const bf16x8 a0 = *(const bf16x8*)(sb + aoff + s * 32), a1 = *(const bf16x8*)(sb + aoff + 32 * LDR + s * 32);
#pragma unroll
            for (int j = 0; j < 4; ++j) {
                const bf16x8 bj = *(const bf16x8*)(sb + boff + j * 32 * LDR + s * 32);
                if constexpr (SWAP) { acc[0][j] = MFMA32(bj, a0, acc[0][j]); acc[1][j] = MFMA32(bj, a1, acc[1][j]); }
                else { acc[0][j] = MFMA32(a0, bj, acc[0][j]); acc[1][j] = MFMA32(a1, bj, acc[1][j]); }
            }
        }
        if (kt + 1 < 32) {
            char* sw = smem + ((kt + 1) & 1) * STAGE;
#pragma unroll
            for (int c = 0; c < 2; ++c) *(u32x4*)(sw + woff + 64 * c * LDR) = ra[c];
#pragma unroll
            for (int c = 0; c < 4; ++c) *(u32x4*)(sw + 128 * LDR + woff + 64 * c * LDR) = rb[c];
            if (kt + 2 < 32) {
#pragma unroll
                for (int c = 0; c < 2; ++c) ra[c] = *(const u32x4*)(Ap + (size_t)(64 * c) * 1024 + (kt + 2) * 32);
#pragma unroll
                for (int c = 0; c < 4; ++c) rb[c] = *(const u32x4*)(Bp + (size_t)(64 * c) * 1024 + (kt + 2) * 32);
            }
        }
        __syncthreads();
    }
}

template <int SEG, int NJ>
DI void inproj_epi(const Params& p, f32x16 (&acc)[2][NJ], int mt, int nt, int wm, int wn, int l31, int hh) {
    float* out = p.out; char* ws = p.ws;
    const bool smp = (mt == 256);
    const int T = smp ? ST : SEQ;
    const int lane_ = l31 + 32 * hh;
    if constexpr (SEG == 2 || SEG == 6 || SEG == 8) {
#pragma unroll
        for (int i = 0; i < 2; ++i)
#pragma unroll
            for (int j = 0; j < NJ; ++j) {
                const int c = (nt & 3) * 128 + wn * (NJ * 32) + j * 32 + l31;
#pragma unroll
                for (int g = 0; g < 4; ++g) {
                    const int rl = wm * 64 + i * 32 + 8 * g + 4 * hh;
                    int b, t;
                    if (!smp) { b = mt >> 6; t = (mt & 63) * 128 + rl; } else { b = rl >> 4; t = rl & 15; }
                    const float v0 = acc[i][j][4 * g], v1 = acc[i][j][4 * g + 1], v2 = acc[i][j][4 * g + 2], v3 = acc[i][j][4 * g + 3];
                    if constexpr (SEG == 2) {
                        const int head = c >> 6, d = c & 63;
                        float* o = out + (smp ? OFF_SVF : OFF_PVF) + ((size_t)(b * 8 + head) * T + t) * 64 + d;
                        o[0] = v0; o[64] = v1; o[128] = v2; o[192] = v3;
                    } else if constexpr (SEG == 6) {
                        const int head = c >> 7, cd = c & 127;
                        float* o = out + (smp ? OFF_SVD : OFF_PVD) + ((size_t)(b * 4 + head) * T + t) * 128 + cd;
                        o[0] = v0; o[128] = v1; o[256] = v2; o[384] = v3;
                    } else {
                        if (wn == 0 && j == 0 && l31 < 8) {
                            const int head = l31;
                            const float bf = p.b_f[head];
                            f32x4 lf; lf.x = logsigmoidf(v0 + bf); lf.y = logsigmoidf(v1 + bf); lf.z = logsigmoidf(v2 + bf); lf.w = logsigmoidf(v3 + bf);
                            *(f32x4*)(out + (smp ? OFF_SLOGF : OFF_PLOGF) + (size_t)(b * 8 + head) * T + t) = lf;
                            if (smp) *(f32x4*)((float*)(ws + WS_LFS) + (size_t)(b * 8 + head) * SKV + PAST + t) = lf;
                        }
                    }
                }
                if constexpr (SEG == 2 || SEG == 6) {
#pragma unroll
                    for (int g = 0; g < 4; g += 2) {
                        const u32x4 w = widen_pair(pk4(acc[i][j][4 * g], acc[i][j][4 * g + 1], acc[i][j][4 * g + 2], acc[i][j][4 * g + 3]),
                                                   pk4(acc[i][j][4 * g + 4], acc[i][j][4 * g + 5], acc[i][j][4 * g + 6], acc[i][j][4 * g + 7]));
                        const int rl = wm * 64 + i * 32 + 8 * g + 8 * hh;
                        int b, t;
                        if (!smp) { b = mt >> 6; t = (mt & 63) * 128 + rl; } else { b = rl >> 4; t = rl & 15; }
                        bf16_t* vt;
                        if constexpr (SEG == 2) {
                            const int head = c >> 6, d = c & 63;
                            vt = smp ? (bf16_t*)(ws + WS_VFTS) + ((size_t)(b * 8 + head) * 64 + d) * SKV + PAST + t
                                     : (bf16_t*)(ws + WS_VFT) + ((size_t)(b * 8 + head) * 64 + d) * SEQ + t;
                        } else {
                            const int head = c >> 7, cd = c & 127;
                            vt = smp ? (bf16_t*)(ws + WS_VDTS) + ((size_t)(b * 4 + head) * 128 + cd) * SKV + PAST + t
                                     : (bf16_t*)(ws + WS_VDT) + ((size_t)(b * 4 + head) * 128 + cd) * SEQ + t;
                        }
                        *(u32x4*)vt = w;
                    }
                }
            }
    } else {
#pragma unroll
        for (int i = 0; i < 2; ++i) {
            const int rl = wm * 64 + i * 32 + l31;
            int b, t;
            if (!smp) { b = mt >> 6; t = (mt & 63) * 128 + rl; } else { b = rl >> 4; t = rl & 15; }
            const size_t tok = (size_t)mt * 128 + rl;
            if constexpr (SEG == 1 || SEG == 5) {
#pragma unroll
                for (int jp = 0; jp < NJ / 2; ++jp) {
                    float ss = 0.f;
#pragma unroll
                    for (int j = 2 * jp; j < 2 * jp + 2; ++j)
#pragma unroll
                        for (int r = 0; r < 16; ++r) ss += acc[i][j][r] * acc[i][j][r];
                    ss += __shfl_xor(ss, 32);
                    ss = max16(ss);
                    if ((lane_ & 47) == 0) {
                        const int c0 = (nt & 3) * 128 + wn * (NJ * 32) + jp * 64;
                        if constexpr (SEG == 1) nrm_max(p, (smp ? NRM_FS : NRM_FP) + b * 8 + (c0 >> 6), ss);
                        else nrm_max(p, (smp ? NRM_DS : NRM_DP) + (b * 4 + (c0 >> 7)) * 2 + ((c0 >> 6) & 1), ss);
                    }
                }
            }
#pragma unroll
            for (int j = 0; j < NJ; ++j) {
                if constexpr (SEG == 1 || SEG == 5) {
#pragma unroll
                    for (int g = 0; g < 4; ++g) {
                        const int c = (nt & 3) * 128 + wn * (NJ * 32) + j * 32 + 8 * g + 4 * hh;
                        f32x4 w; w.x = acc[i][j][4 * g]; w.y = acc[i][j][4 * g + 1]; w.z = acc[i][j][4 * g + 2]; w.w = acc[i][j][4 * g + 3];
                        float* o;
                        if constexpr (SEG == 1) o = out + (smp ? OFF_SKF : OFF_PKF) + ((size_t)(b * 8 + (c >> 6)) * T + t) * 64 + (c & 63);
                        else o = out + (smp ? OFF_SKD : OFF_PKD) + ((size_t)(b * 4 + (c >> 7)) * T + t) * 128 + (c & 127);
                        *(f32x4*)o = w;
                    }
                }
#pragma unroll
                for (int g = 0; g < 4; g += 2) {
                    float v[8];
#pragma unroll
                    for (int e = 0; e < 8; ++e) v[e] = acc[i][j][4 * g + e];
                    if constexpr (SEG == 0 || SEG == 4) {
#pragma unroll
                        for (int e = 0; e < 8; ++e) v[e] *= QSCALE;
                    } else if constexpr (SEG == 3 || SEG == 7) {
#pragma unroll
                        for (int e = 0; e < 8; ++e) v[e] = siluf(v[e]);
                    }
                    const u32x4 w = widen_pair(pk4(v[0], v[1], v[2], v[3]), pk4(v[4], v[5], v[6], v[7]));
                    const int c = (nt & 3) * 128 + wn * (NJ * 32) + j * 32 + 8 * g + 8 * hh;
                    bf16_t* dst;
                    if constexpr (SEG == 0) dst = (bf16_t*)(ws + (smp ? WS_QFS : WS_QF)) + ((size_t)(b * 8 + (c >> 6)) * T + t) * 64 + (c & 63);
                    else if constexpr (SEG == 1) dst = smp ? (bf16_t*)(ws + WS_KFS) + ((size_t)(b * 8 + (c >> 6)) * SKV + PAST + t) * 64 + (c & 63)
                                                           : (bf16_t*)(ws + WS_KF) + ((size_t)(b * 8 + (c >> 6)) * SEQ + t) * 64 + (c & 63);
                    else if constexpr (SEG == 3 || SEG == 7) dst = (bf16_t*)(ws + WS_G) + tok * 1024 + (SEG == 7 ? 512 : 0) + c;
                    else if constexpr (SEG == 4) dst = (bf16_t*)(ws + (smp ? WS_QDS : WS_QD)) + ((size_t)(b * 4 + (c >> 7)) * T + t) * 128 + (c & 127);
                    else dst = smp ? (bf16_t*)(ws + WS_KDS) + ((size_t)(b * 4 + (c >> 7)) * SKV + PAST + t) * 128 + (c & 127)
                                   : (bf16_t*)(ws + WS_KD) + ((size_t)(b * 4 + (c >> 7)) * SEQ + t) * 128 + (c & 127);
                    *(u32x4*)dst = w;
                }
            }
        }
    }
}

DI void phase2_tile(const Params& p, int mt, int nt, char* smem) {
    const int tid = threadIdx.x, lane = tid & 63, wave = tid >> 6, l31 = lane & 31, hh = lane >> 5, wm = wave & 1, wn = wave >> 1;
    f32x16 acc[2][2];
    gemm_mainloop_db<false>((const bf16_t*)(p.ws + WS_H) + (size_t)mt * 128 * 1024, (const bf16_t*)(p.ws + WS_WTIN) + (size_t)nt * 128 * 1024, smem, acc);
    inproj_epi<8, 2>(p, acc, mt, nt, wm, wn, l31, hh);
}

DI void phase2_tile_w(const Params& p, int mt, int nt, char* smem) {
    int tid_ = threadIdx.x;
    asm volatile("" : "+v"(tid_));
    const int tid = tid_, lane = tid & 63, wave = tid >> 6, l31 = lane & 31, hh = lane >> 5, wm = wave & 1, wn = wave >> 1;
    f32x16 acc[2][4];
    const bf16_t* A = (const bf16_t*)(p.ws + WS_H) + (size_t)mt * 128 * 1024;
    const bf16_t* B = (const bf16_t*)(p.ws + WS_WTIN) + (size_t)nt * 128 * 1024;
    const int seg = nt >> 2;
    if (seg == 2 || seg == 6) {
        gemm_mainloop_w<false>(A, B, smem, acc);
        if (seg == 2) inproj_epi<2, 4>(p, acc, mt, nt, wm, wn, l31, hh);
        else inproj_epi<6, 4>(p, acc, mt, nt, wm, wn, l31, hh);
    } else {
        gemm_mainloop_w<true>(A, B, smem, acc);
        switch (seg) {
            case 0: inproj_epi<0, 4>(p, acc, mt, nt, wm, wn, l31, hh); break;
            case 1: inproj_epi<1, 4>(p, acc, mt, nt, wm, wn, l31, hh); break;
            case 3: inproj_epi<3, 4>(p, acc, mt, nt, wm, wn, l31, hh); break;
            case 4: inproj_epi<4, 4>(p, acc, mt, nt, wm, wn, l31, hh); break;
            case 5: inproj_epi<5, 4>(p, acc, mt, nt, wm, wn, l31, hh); break;
            default: inproj_epi<7, 4>(p, acc, mt, nt, wm, wn, l31, hh); break;
        }
    }
}

constexpr int P2_PER_X = 512 + 32 + 3;
DI int phase2_decode(int v, int q, int& mt, int& nt) {
    if (q < 512) { const int r = q >> 6, lb = q & 63; mt = 32 * v + 8 * (r >> 1) + (lb & 7); nt = 2 * (8 * (r & 1) + (lb >> 3)); return 1; }
    if (q < 544) { mt = 32 * v + (q - 512); nt = 32; return 2; }
    const int k = q - 544;
    mt = 256;
    if (k < 2) { nt = 2 * (v + 8 * k); return 1; }
    if (v == 0) { nt = 32; return 2; }
    return 0;
}

DI bf16x8 pack8(const f32x16& x, int s) {
    u32x4 r;
    r.x = pk2(x[8 * s + 0], x[8 * s + 1]); r.y = pk2(x[8 * s + 2], x[8 * s + 3]);
    r.z = pk2(x[8 * s + 4], x[8 * s + 5]); r.w = pk2(x[8 * s + 6], x[8 * s + 7]);
    return __builtin_bit_cast(bf16x8, r);
}
DI bf16x8 ldv_frag(const char* base) {
    const u32x2 lo = *(const u32x2*)base, hi = *(const u32x2*)(base + 16);
    u32x4 r; r.x = lo.x; r.y = lo.y; r.z = hi.x; r.w = hi.y;
    return __builtin_bit_cast(bf16x8, r);
}

DI void fox_item(const Params& p, char* smem, int smp, int b, int h, int qb) {
    int tid_ = threadIdx.x;
    asm volatile("" : "+v"(tid_));
    const int tid = tid_, lane = tid & 63, wave = tid >> 6, l31 = lane & 31, hh = lane >> 5;
    const int bh = b * 8 + h;
    const bf16_t *Q, *K, *Vt; const float* lf; int ldv, qpos0, nq; size_t tok0;
    if (!smp) {
        Q = (const bf16_t*)(p.ws + WS_QF) + ((size_t)bh * SEQ + qb * 128) * 64; K = (const bf16_t*)(p.ws + WS_KF) + (size_t)bh * SEQ * 64;
        Vt = (const bf16_t*)(p.ws + WS_VFT) + (size_t)bh * 64 * SEQ; ldv = SEQ; lf = p.out + OFF_PLOGF + (size_t)bh * SEQ;
        qpos0 = qb * 128; nq = 128; tok0 = (size_t)b * SEQ + qb * 128;
    } else {
        Q = (const bf16_t*)(p.ws + WS_QFS) + (size_t)bh * 16 * 64; K = (const bf16_t*)(p.ws + WS_KFS) + (size_t)bh * SKV * 64;
        Vt = (const bf16_t*)(p.ws + WS_VFTS) + (size_t)bh * 64 * SKV; ldv = SKV; lf = (const float*)(p.ws + WS_LFS) + (size_t)bh * SKV;
        qpos0 = PAST; nq = 16; tok0 = (size_t)MP + b * 16;
    }
    const int nkv = qpos0 + nq, ntiles = (nkv + 63) >> 6;
    float* cum = (float*)smem;
    char* bufs = smem + 32768;
    float* wsum = (float*)(smem + 32768 + 2 * 18432);
    {
        const int base = tid * 32;
        float s = 0.f;
        if (base < nkv) {
#pragma unroll
            for (int e = 0; e < 8; ++e) {
                if (base + 4 * e < nkv) { const f32x4 v = *(const f32x4*)(lf + base + 4 * e); s += (v.x + v.y) + (v.z + v.w); }
            }
        }
        float inc = s;
#pragma unroll
        for (int o = 1; o < 64; o <<= 1) { const float u = __shfl_up(inc, o); if (lane >= o) inc += u; }
        if (lane == 63) wsum[wave] = inc;
        __syncthreads();
        float run = inc - s;
        for (int w = 0; w < wave; ++w) run += wsum[w];
        if (base < ntiles * 64) {
#pragma unroll
            for (int e = 0; e < 8; ++e) {
                f32x4 v = {0.f, 0.f, 0.f, 0.f};
                if (base + 4 * e < nkv) v = *(const f32x4*)(lf + base + 4 * e);
                f32x4 o;
                run += v.x; o.x = run * LOG2E; run += v.y; o.y = run * LOG2E; run += v.z; o.z = run * LOG2E; run += v.w; o.w = run * LOG2E;
                *(f32x4*)(cum + base + 4 * e) = o;
            }
        }
        __syncthreads();
    }
    const int qrow = min(wave * 32 + l31, nq - 1), qpos = qpos0 + qrow;
    const int wave_qmin = qpos0 + min(wave * 32, nq - 1), wave_qmax = qpos0 + min(wave * 32 + 31, nq - 1);
    bf16x8 qf[4];
#pragma unroll
    for (int s = 0; s < 4; ++s) qf[s] = *(const bf16x8*)(Q + (size_t)qrow * 64 + 16 * s + 8 * hh);
    const float cumq = cum[qpos];
    float B2;
    {
        float ss = 0.f;
#pragma unroll
        for (int s = 0; s < 4; ++s) ss += sq8(__builtin_bit_cast(u32x4, qf[s]));
        ss += __shfl_xor(ss, 32);
        ss = max16(ss); ss = fmaxf(ss, __shfl_xor(ss, 16));
        if (lane == 0) wsum[4 + wave] = ss;
        __syncthreads();
        const float q2 = fmaxf(fmaxf(wsum[4], wsum[5]), fmaxf(wsum[6], wsum[7]));
        const float k2 = __uint_as_float(((const unsigned*)(p.ws + WS_NRM))[(smp ? NRM_FS : NRM_FP) + bh]);
        B2 = 1.02f * sqrtf(q2 * k2) + 0.5f;
    }
    const bool robust = (B2 > FAST_B2_MAX);
    const float thr = robust ? -150.f - 2.f * B2 : -150.f;
    const float cumq0 = cum[qpos0];
    float ref = B2;
    f32x16 O[2];
    float lsum = 0.f;
    const int ldrow = tid >> 3, ldk = (tid & 7) * 8;
    u32x4 kreg[2], vreg[2];
    auto load_tile = [&](int j) {
        const int k0 = j * 64;
#pragma unroll
        for (int c = 0; c < 2; ++c) {
            kreg[c] = *(const u32x4*)(K + (size_t)(k0 + ldrow + 32 * c) * 64 + ldk);
            vreg[c] = *(const u32x4*)(Vt + (size_t)(ldrow + 32 * c) * ldv + k0 + ldk);
        }
    };
    auto run_pass = [&](auto prepass_tag) {
        constexpr bool PRE = decltype(prepass_tag)::value;
        const float cq = PRE ? cumq : cumq - ref;
        float mrow = -INFINITY;
        load_tile(ntiles - 1);
        int buf = 0;
        for (int j = ntiles - 1; j >= 0; --j, buf ^= 1) {
            char* sK = bufs + buf * 18432; char* sV = sK + 9216;
#pragma unroll
            for (int c = 0; c < 2; ++c) {
                *(u32x4*)(sK + (ldrow + 32 * c) * 144 + ldk * 2) = kreg[c];
                { char* wv = sV + (ldrow + 32 * c) * 136 + ldk * 2; u32x2 lo, hi; lo.x = vreg[c].x; lo.y = vreg[c].y; hi.x = vreg[c].z; hi.y = vreg[c].w;
                  *(u32x2*)wv = lo; *(u32x2*)(wv + 8) = hi; }
            }
            if (j > 0) load_tile(j - 1);
            __syncthreads();
            const int k0 = j * 64;
            if (!PRE && k0 + 63 < qpos0 && (cumq0 - cum[k0 + 63]) < thr) break;
            if (k0 <= wave_qmax) {
                f32x16 X[2];
#pragma unroll
                for (int sub = 0; sub < 2; ++sub)
#pragma unroll
                    for (int g = 0; g < 4; ++g) {
                        const f32x4 ck = *(const f32x4*)(cum + k0 + 32 * sub + 8 * g + 4 * hh);
                        X[sub][4 * g] = cq - ck.x; X[sub][4 * g + 1] = cq - ck.y; X[sub][4 * g + 2] = cq - ck.z; X[sub][4 * g + 3] = cq - ck.w;
                    }
#pragma unroll
                for (int sub = 0; sub < 2; ++sub)
#pragma unroll
                    for (int s = 0; s < 4; ++s) {
                        const bf16x8 kf = *(const bf16x8*)(sK + (32 * sub + l31) * 144 + s * 32 + hh * 16);
                        X[sub] = MFMA32(kf, qf[s], X[sub]);
                    }
                if (k0 + 63 > wave_qmin) {
#pragma unroll
                    for (int sub = 0; sub < 2; ++sub)
#pragma unroll
                        for (int r = 0; r < 16; ++r)
                            if (k0 + 32 * sub + 8 * (r >> 2) + 4 * hh + (r & 3) > qpos) X[sub][r] = -INFINITY;
                }
                if constexpr (PRE) {
#pragma unroll
                    for (int r = 0; r < 16; ++r) mrow = fmaxf(fmaxf(mrow, X[0][r]), X[1][r]);
                } else {
                    float ps = 0.f;
#pragma unroll
                    for (int sub = 0; sub < 2; ++sub)
#pragma unroll
                        for (int r = 0; r < 16; ++r) { const float pv = ex2(X[sub][r]); X[sub][r] = pv; ps += pv; }
                    lsum += ps;
#pragma unroll
                    for (int sub = 0; sub < 2; ++sub)
#pragma unroll
                        for (int s = 0; s < 2; ++s) {
                            const bf16x8 pf = pack8(X[sub], s);
#pragma unroll
                            for (int dt = 0; dt < 2; ++dt) {
                                const bf16x8 vf = ldv_frag(sV + (32 * dt + l31) * 136 + (32 * sub + 16 * s + 4 * hh) * 2);
                                O[dt] = MFMA32(vf, pf, O[dt]);
                            }
                        }
                }
            }
        }
        return mrow;
    };
    if (robust) {
        const float mr = run_pass(std::true_type{});
        ref = fmaxf(mr, __shfl_xor(mr, 32));
        __syncthreads();
    }
#pragma unroll
    for (int dt = 0; dt < 2; ++dt)
#pragma unroll
        for (int r = 0; r < 16; ++r) O[dt][r] = 0.f;
    run_pass(std::false_type{});
    const float l = lsum + __shfl_xor(lsum, 32), inv = 1.f / l;
    if (wave * 32 + l31 < nq) {
        const size_t tok = tok0 + wave * 32 + l31;
        const bf16_t* gp = (const bf16_t*)(p.ws + WS_G) + tok * 1024 + h * 64;
        bf16_t* up = (bf16_t*)(p.ws + WS_H) + tok * 1024 + h * 64;
#pragma unroll
        for (int dt = 0; dt < 2; ++dt)
#pragma unroll
            for (int g = 0; g < 4; ++g) {
                const int d0 = 32 * dt + 8 * g + 4 * hh;
                const u32x2 gg = *(const u32x2*)(gp + d0);
                const float g0 = __uint_as_float(gg.x << 16), g1 = __uint_as_float(gg.x & 0xffff0000u), g2 = __uint_as_float(gg.y << 16), g3 = __uint_as_float(gg.y & 0xffff0000u);
                u32x2 o;
                o.x = pk2(O[dt][4 * g] * inv * g0, O[dt][4 * g + 1] * inv * g1);
                o.y = pk2(O[dt][4 * g + 2] * inv * g2, O[dt][4 * g + 3] * inv * g3);
                *(u32x2*)(up + d0) = o;
            }
    }
    __syncthreads();
}

DI void diff_item(const Params& p, char* smem, int smp, int b, int h, int qb, float lam) {
    int tid_ = threadIdx.x;
    asm volatile("" : "+v"(tid_));
    const int tid = tid_, lane = tid & 63, wave = tid >> 6, l31 = lane & 31, hh = lane >> 5;
    const int rg = wave >> 1, cm = wave & 1;
    const int bh = b * 4 + h;
    const bf16_t *Q, *K, *Vt; int ldv, qpos0, nq, nkv; size_t tok0;
    if (!smp) {
        Q = (const bf16_t*)(p.ws + WS_QD) + ((size_t)bh * SEQ + qb * 64) * 128; K = (const bf16_t*)(p.ws + WS_KD) + (size_t)bh * SEQ * 128;
        Vt = (const bf16_t*)(p.ws + WS_VDT) + (size_t)bh * 128 * SEQ; ldv = SEQ; qpos0 = qb * 64; nq = 64; nkv = qpos0 + 64; tok0 = (size_t)b * SEQ + qb * 64;
    } else {
        Q = (const bf16_t*)(p.ws + WS_QDS) + (size_t)bh * 16 * 128; K = (const bf16_t*)(p.ws + WS_KDS) + (size_t)bh * SKV * 128;
        Vt = (const bf16_t*)(p.ws + WS_VDTS) + (size_t)bh * 128 * SKV; ldv = SKV; qpos0 = PAST; nq = 16; nkv = PAST + 16; tok0 = (size_t)MP + b * 16;
    }
    const int ntiles = (nkv + 63) >> 6;
    const float slope2 = ex2(-2.f * (float)(h + 1)) * LOG2E;
    const int qrow = min(rg * 32 + l31, nq - 1), qpos = qpos0 + qrow;
    bf16x8 qf[4];
#pragma unroll
    for (int s = 0; s < 4; ++s) qf[s] = *(const bf16x8*)(Q + (size_t)qrow * 128 + cm * 64 + 16 * s + 8 * hh);
    float B2;
    {
        float* scr = (float*)(smem + 71680);
        float ss = 0.f;
#pragma unroll
        for (int s = 0; s < 4; ++s) ss += sq8(__builtin_bit_cast(u32x4, qf[s]));
        ss += __shfl_xor(ss, 32);
        ss = max16(ss); ss = fmaxf(ss, __shfl_xor(ss, 16));
        if (lane == 0) scr[wave] = ss;
        __syncthreads();
        const float q2 = fmaxf(fmaxf(scr[0], scr[1]), fmaxf(scr[2], scr[3]));
        const unsigned* nk = (const unsigned*)(p.ws + WS_NRM) + (smp ? NRM_DS : NRM_DP) + bh * 2;
        const float k2 = fmaxf(__uint_as_float(nk[0]), __uint_as_float(nk[1]));
        B2 = 1.02f * sqrtf(q2 * k2) + 0.5f;
    }
    const bool robust = (B2 > FAST_B2_MAX);
    const float thr = robust ? -150.f - 2.f * B2 : -150.f;
    float ref = B2;
    f32x16 O[4];
    float lsum = 0.f;
    u32x4 kreg[4], vreg[4];
    const int krow_ = tid >> 4, kck = (tid & 15) * 8, vrow_ = tid >> 3, vck = (tid & 7) * 8;
    auto load_tile = [&](int j) {
        const int k0 = j * 64;
#pragma unroll
        for (int c = 0; c < 4; ++c) {
            kreg[c] = *(const u32x4*)(K + (size_t)(k0 + krow_ + 16 * c) * 128 + kck);
            vreg[c] = *(const u32x4*)(Vt + (size_t)(vrow_ + 32 * c) * ldv + k0 + vck);
        }
    };
    auto run_pass = [&](auto prepass_tag) {
        constexpr bool PRE = decltype(prepass_tag)::value;
        const float rf = PRE ? 0.f : ref;
        float mrow = -INFINITY;
        load_tile(ntiles - 1);
        int buf = 0;
        for (int j = ntiles - 1; j >= 0; --j, buf ^= 1) {
            char* sK = smem + buf * 35840; char* sV = sK + 17408;
#pragma unroll
            for (int c = 0; c < 4; ++c) {
                *(u32x4*)(sK + (krow_ + 16 * c) * 272 + kck * 2) = kreg[c];
                { char* wv = sV + (vrow_ + 32 * c) * 136 + vck * 2; u32x2 lo, hi; lo.x = vreg[c].x; lo.y = vreg[c].y; hi.x = vreg[c].z; hi.y = vreg[c].w;
                  *(u32x2*)wv = lo; *(u32x2*)(wv + 8) = hi; }
            }
            if (j > 0) load_tile(j - 1);
            __syncthreads();
            const int k0 = j * 64;
            if (!PRE && k0 + 63 < qpos0 && -slope2 * (float)(qpos0 - (k0 + 63)) < thr) break;
            const bool diag = (k0 + 63 >= qpos0);
            f32x16 X[2];
            if (!diag) {
                float bb = slope2 * (float)(k0 + 4 * hh - qpos) - rf;
                const float s2 = slope2 + slope2, s3 = s2 + slope2, s8 = 8.f * slope2;
#pragma unroll
                for (int sub = 0; sub < 2; ++sub)
#pragma unroll
                    for (int g = 0; g < 4; ++g) {
                        X[sub][4 * g] = bb; X[sub][4 * g + 1] = bb + slope2; X[sub][4 * g + 2] = bb + s2; X[sub][4 * g + 3] = bb + s3;
                        bb += s8;
                    }
            } else {
#pragma unroll
                for (int sub = 0; sub < 2; ++sub)
#pragma unroll
                    for (int r = 0; r < 16; ++r) X[sub][r] = 0.f;
            }
#pragma unroll
            for (int sub = 0; sub < 2; ++sub)
#pragma unroll
                for (int s = 0; s < 4; ++s) {
                    const bf16x8 kf = *(const bf16x8*)(sK + (32 * sub + l31) * 272 + cm * 128 + s * 32 + hh * 16);
                    X[sub] = MFMA32(kf, qf[s], X[sub]);
                }
            if (diag) {
                const bool need_mask = (k0 + 64 > nkv);
                float qd = (float)(qpos - k0 - 4 * hh);
#pragma unroll
                for (int sub = 0; sub < 2; ++sub)
#pragma unroll
                    for (int g = 0; g < 4; ++g) {
#pragma unroll
                        for (int e = 0; e < 4; ++e) {
                            float x = X[sub][4 * g + e] - slope2 * fabsf(qd - (float)e) - rf;
                            if (need_mask && (k0 + 4 * hh + 32 * sub + 8 * g + e >= nkv)) x = -INFINITY;
                            X[sub][4 * g + e] = x;
                        }
                        qd -= 8.f;
                    }
            }
            if constexpr (PRE) {
#pragma unroll
                for (int r = 0; r < 16; ++r) mrow = fmaxf(fmaxf(mrow, X[0][r]), X[1][r]);
            } else {
                float ps = 0.f;
#pragma unroll
                for (int sub = 0; sub < 2; ++sub)
#pragma unroll
                    for (int r = 0; r < 16; ++r) { const float pv = ex2(X[sub][r]); X[sub][r] = pv; ps += pv; }
                lsum += ps;
#pragma unroll
                for (int sub = 0; sub < 2; ++sub)
#pragma unroll
                    for (int s = 0; s < 2; ++s) {
                        const bf16x8 pf = pack8(X[sub], s);
#pragma unroll
                        for (int dt = 0; dt < 4; ++dt) {
                            const bf16x8 vf = ldv_frag(sV + (32 * dt + l31) * 136 + (32 * sub + 16 * s + 4 * hh) * 2);
                            O[dt] = MFMA32(vf, pf, O[dt]);
                        }
                    }
            }
        }
        return mrow;
    };
    if (robust) {
        const float mr = run_pass(std::true_type{});
        ref = fmaxf(mr, __shfl_xor(mr, 32));
        __syncthreads();
    }
#pragma unroll
    for (int dt = 0; dt < 4; ++dt)
#pragma unroll
        for (int r = 0; r < 16; ++r) O[dt][r] = 0.f;
    run_pass(std::false_type{});
    const float L = lsum + __shfl_xor(lsum, 32);
    __syncthreads();
    float* xch = (float*)smem + (size_t)rg * 4096;
    if (cm == 1) {
        const float i1 = lam / L;
#pragma unroll
        for (int dt = 0; dt < 4; ++dt)
#pragma unroll
            for (int r = 0; r < 16; ++r) xch[(dt * 16 + r) * 64 + lane] = O[dt][r] * i1;
    }
    __syncthreads();
    if (cm == 0) {
        const float i0 = 1.f / L;
        float ss = 0.f;
#pragma unroll
        for (int dt = 0; dt < 4; ++dt)
#pragma unroll
            for (int r = 0; r < 16; ++r) { const float o = O[dt][r] * i0 - xch[(dt * 16 + r) * 64 + lane]; O[dt][r] = o; ss += o * o; }
        ss += __shfl_xor(ss, 32);
        const float rs = rsqrtf(ss * (1.f / 128.f) + 1e-5f) * 0.8f;
        if (rg * 32 + l31 < nq) {
            const size_t tok = tok0 + rg * 32 + l31;
            const bf16_t* gp = (const bf16_t*)(p.ws + WS_G) + tok * 1024 + 512 + h * 128;
            bf16_t* up = (bf16_t*)(p.ws + WS_H) + tok * 1024 + 512 + h * 128;
#pragma unroll
            for (int dt = 0; dt < 4; ++dt)
#pragma unroll
                for (int g = 0; g < 4; ++g) {
                    const int d0 = 32 * dt + 8 * g + 4 * hh;
                    const u32x2 gg = *(const u32x2*)(gp + d0);
                    const f32x4 sg = *(const f32x4*)(p.subln_g + d0);
                    const float g0 = __uint_as_float(gg.x << 16), g1 = __uint_as_float(gg.x & 0xffff0000u), g2 = __uint_as_float(gg.y << 16), g3 = __uint_as_float(gg.y & 0xffff0000u);
                    u32x2 o;
                    o.x = pk2(O[dt][4 * g] * rs * sg.x * g0, O[dt][4 * g + 1] * rs * sg.y * g1);
                    o.y = pk2(O[dt][4 * g + 2] * rs * sg.z * g2, O[dt][4 * g + 3] * rs * sg.w * g3);
                    *(u32x2*)(up + d0) = o;
                }
        }
    }
    __syncthreads();
}

constexpr int AT_PER_X = 8 + 4 + 256 + 256;
DI void attn_item(const Params& p, char* smem, int v, int q, float lam) {
    int kind, smp, b, h, qb;
    if (q < 8) { kind = 0; smp = 1; b = v; h = q; qb = 0; }
    else if (q < 12) { kind = 1; smp = 1; b = v; h = q - 8; qb = 0; }
    else if (q < 268) {
        const int r = q - 12, second = r >> 7; kind = 1; smp = 0; qb = 127 - (r & 127); b = v >> 1;
        h = (v & 1) ? (second ? 1 : 2) : (second ? 0 : 3); }
    else { const int r = q - 268, rr = r & 127, bh = 4 * v + 2 * (r >> 7) + (rr & 1); kind = 0; smp = 0; qb = 63 - (rr >> 1); b = bh >> 3; h = bh & 7; }
    if (kind == 0) fox_item(p, smem, smp, b, h, qb);
    else diff_item(p, smem, smp, b, h, qb, lam);
}

DI void ln_rows(const Params& p, float* y0, int nrows, int lane) {
#pragma unroll 1
    for (int r = 0; r < nrows; r += 2) {
        float* yr = y0 + (size_t)r * 1024;
        f32x4 v[2][4];
#pragma unroll
        for (int a = 0; a < 2; ++a)
#pragma unroll
            for (int q = 0; q < 4; ++q) v[a][q] = *(const f32x4*)(yr + a * 1024 + q * 256 + lane * 4);
        float mu[2], rstd[2];
#pragma unroll
        for (int a = 0; a < 2; ++a) {
            float s = 0.f;
#pragma unroll
            for (int q = 0; q < 4; ++q) s += (v[a][q].x + v[a][q].y) + (v[a][q].z + v[a][q].w);
            mu[a] = wave_sum(s) * (1.f / 1024.f);
            float s2 = 0.f;
#pragma unroll
            for (int q = 0; q < 4; ++q) { v[a][q].x -= mu[a]; v[a][q].y -= mu[a]; v[a][q].z -= mu[a]; v[a][q].w -= mu[a]; s2 += (v[a][q].x * v[a][q].x + v[a][q].y * v[a][q].y) + (v[a][q].z * v[a][q].z + v[a][q].w * v[a][q].w); }
            rstd[a] = rsqrtf(wave_sum(s2) * (1.f / 1024.f) + 1e-5f);
        }
#pragma unroll
        for (int q = 0; q < 4; ++q) {
            const f32x4 gq = *(const f32x4*)(p.ln_g + q * 256 + lane * 4), bq = *(const f32x4*)(p.ln_b + q * 256 + lane * 4);
#pragma unroll
            for (int a = 0; a < 2; ++a) {
                f32x4 o;
                o.x = v[a][q].x * rstd[a] * gq.x + bq.x; o.y = v[a][q].y * rstd[a] * gq.y + bq.y;
                o.z = v[a][q].z * rstd[a] * gq.z + bq.z; o.w = v[a][q].w * rstd[a] * gq.w + bq.w;
                *(f32x4*)(yr + a * 1024 + q * 256 + lane * 4) = o;
            }
        }
    }
}

DI void phase4_tile(const Params& p, int mt, char* smem) {
    int tid_ = threadIdx.x;
    asm volatile("" : "+v"(tid_));
    const int tid = tid_, lane = tid & 63, wave = tid >> 6, l31 = lane & 31, hh = lane >> 5;
    const bf16_t* A = (const bf16_t*)(p.ws + WS_H) + (size_t)mt * 64 * 1024;
    float* y = p.out + (size_t)mt * 64 * 1024;
    const float* gate = (const float*)(p.ws + WS_MOD) + ((mt * 64) >> 13) * 3072 + 2048;
    for (int nc = 0; nc < 4; ++nc) {
        f32x16 acc[2][2];
        gemm_mainloop<64, 256, 1, true>(A, (const bf16_t*)(p.ws + WS_WTOUT) + (size_t)nc * 256 * 1024, smem, acc);
        const int cb = nc * 256 + wave * 64 + 4 * hh;
#pragma unroll
        for (int i = 0; i < 2; ++i) {
            const int rl = i * 32 + l31;
            const float* xr = p.x_p + (size_t)(mt * 64 + rl) * 1024 + cb;
            float* yr = y + (size_t)rl * 1024 + cb;
            f32x4 xv[2][4];
#pragma unroll
            for (int j = 0; j < 2; ++j)
#pragma unroll
                for (int g = 0; g < 4; ++g) xv[j][g] = *(const f32x4*)(xr + j * 32 + 8 * g);
#pragma unroll
            for (int j = 0; j < 2; ++j)
#pragma unroll
                for (int g = 0; g < 4; ++g) {
                    const f32x4 gt = *(const f32x4*)(gate + cb + j * 32 + 8 * g);
                    f32x4 o;
                    o.x = ALPHA * xv[j][g].x + gt.x * acc[i][j][4 * g]; o.y = ALPHA * xv[j][g].y + gt.y * acc[i][j][4 * g + 1];
                    o.z = ALPHA * xv[j][g].z + gt.z * acc[i][j][4 * g + 2]; o.w = ALPHA * xv[j][g].w + gt.w * acc[i][j][4 * g + 3];
                    *(f32x4*)(yr + j * 32 + 8 * g) = o;
                }
        }
    }
    __threadfence_block();
    __syncthreads();
    ln_rows(p, y + (size_t)(wave * 16) * 1024, 16, lane);
    __syncthreads();
}

DI float dot8(u32x4 a, u32x4 b, float acc) {
    acc += __uint_as_float(a.x << 16) * __uint_as_float(b.x << 16); acc += __uint_as_float(a.x & 0xffff0000u) * __uint_as_float(b.x & 0xffff0000u);
    acc += __uint_as_float(a.y << 16) * __uint_as_float(b.y << 16); acc += __uint_as_float(a.y & 0xffff0000u) * __uint_as_float(b.y & 0xffff0000u);
    acc += __uint_as_float(a.z << 16) * __uint_as_float(b.z << 16); acc += __uint_as_float(a.z & 0xffff0000u) * __uint_as_float(b.z & 0xffff0000u);
    acc += __uint_as_float(a.w << 16) * __uint_as_float(b.w << 16); acc += __uint_as_float(a.w & 0xffff0000u) * __uint_as_float(b.w & 0xffff0000u);
    return acc;
}
DI void sample_out_task(const Params& p, int task, int* s_flag) {
    int tid_ = threadIdx.x;
    asm volatile("" : "+v"(tid_));
    const int tid = tid_, lane = tid & 63, wave = tid >> 6;
    const int b8 = task >> 5, cg = task & 31, row = b8 * 16 + (tid >> 4), col = cg * 32 + (tid & 15) * 2;
    const bf16_t* u = (const bf16_t*)(p.ws + WS_H) + (size_t)(MP + row) * 1024;
    const bf16_t* w0 = (const bf16_t*)(p.ws + WS_WTOUT) + (size_t)col * 1024;
    float a0 = 0.f, a1 = 0.f;
#pragma unroll 4
    for (int c = 0; c < 128; ++c) {
        const u32x4 uu = *(const u32x4*)(u + c * 8);
        a0 = dot8(uu, *(const u32x4*)(w0 + c * 8), a0);
        a1 = dot8(uu, *(const u32x4*)(w0 + 1024 + c * 8), a1);
    }
    const float* gate = (const float*)(p.ws + WS_MOD) + (4 + b8) * 3072 + 2048;
    const float* xr = p.x_s + (size_t)row * 1024;
    float* y = p.out + (size_t)(MP + row) * 1024;
    f32x2 o; o.x = ALPHA * xr[col] + gate[col] * a0; o.y = ALPHA * xr[col + 1] + gate[col + 1] * a1;
    *(f32x2*)(y + col) = o;
    asm volatile("s_waitcnt vmcnt(0)" ::: "memory");
    __syncthreads();
    if (tid == 0) {
        __builtin_amdgcn_fence(__ATOMIC_RELEASE, "agent");
        asm volatile("s_waitcnt vmcnt(0)" ::: "memory");
        const int last = (atomicAdd((int*)(p.ws + WS_CTR) + 8 + b8, 1) == 31);
        if (last) { __builtin_amdgcn_fence(__ATOMIC_ACQUIRE, "agent"); asm volatile("s_waitcnt vmcnt(0)" ::: "memory"); }
        *s_flag = last;
    }
    __syncthreads();
    if (*s_flag) {
        ln_rows(p, p.out + (size_t)(MP + b8 * 16 + wave * 4) * 1024, 4, lane);
    }
    __syncthreads();
}

#define XB_XCNT(j) (64 * (j))
#define XB_XSUB(j) (64 * (16 + (j)))
#define XB_XGEN(j) (64 * (32 + (j)))
#define XB_TOP (64 * 48)
#define XB_TOPGEN (64 * 49)
DI unsigned bar_ld(unsigned* p) { return __hip_atomic_load(p, __ATOMIC_RELAXED, __HIP_MEMORY_SCOPE_AGENT); }
DI unsigned bar_add(unsigned* p) { return __hip_atomic_fetch_add(p, 1u, __ATOMIC_RELAXED, __HIP_MEMORY_SCOPE_AGENT); }
DI unsigned xcc_id() { return (unsigned)__builtin_amdgcn_s_getreg((3 << 11) | 20) & 0xFu; }
DI void grid_barrier(unsigned* bar, volatile unsigned* st  ) {
    asm volatile("s_waitcnt vmcnt(0)" ::: "memory");
    __syncthreads();
    if (threadIdx.x == 0) {
        __builtin_amdgcn_s_waitcnt(0);
        const unsigned x = xcc_id();
        unsigned nloc = st[0], nx = st[1];
        if (nloc == 0u) {
            const unsigned G = gridDim.x;
            unsigned sum, cnt, mine, sp = 0u;
            for (;;) {
                sum = 0u; cnt = 0u; mine = 0u;
#pragma unroll
                for (unsigned j = 0; j < 16; ++j) { const unsigned c = bar_ld(&bar[XB_XCNT(j)]); sum += c; cnt += (c > 0u) ? 1u : 0u; mine = (j == x) ? c : mine; }
                if (sum == G || ++sp > (1u << 22)) break;
                __builtin_amdgcn_s_sleep(1);
            }
            nloc = mine > 0u ? mine : 1u; nx = cnt > 0u ? cnt : 1u;
            st[0] = nloc; st[1] = nx;
        }
        const unsigned old = bar_add(&bar[XB_XSUB(x)]);
        const unsigned gen = old / nloc;
        unsigned sp = 0u;
        if (old + 1u == (gen + 1u) * nloc) {
            __builtin_amdgcn_fence(__ATOMIC_RELEASE, "agent");
            asm volatile("s_waitcnt vmcnt(0)" ::: "memory");
            const unsigned og = bar_add(&bar[XB_TOP]);
            const unsigned tg = og / nx;
            if (og + 1u == (tg + 1u) * nx) bar_add(&bar[XB_TOPGEN]);
            else while (bar_ld(&bar[XB_TOPGEN]) == tg && ++sp < (1u << 24)) __builtin_amdgcn_s_sleep(1);
            __builtin_amdgcn_fence(__ATOMIC_ACQUIRE, "agent");
            bar_add(&bar[XB_XGEN(x)]);
            asm volatile("s_waitcnt vmcnt(0)" ::: "memory");
        } else {
            while (bar_ld(&bar[XB_XGEN(x)]) == gen && ++sp < (1u << 24)) __builtin_amdgcn_s_sleep(1);
            __builtin_amdgcn_fence(__ATOMIC_ACQUIRE, "agent");
            asm volatile("s_waitcnt vmcnt(0)" ::: "memory");
        }
    }
    __syncthreads();
}

template <int MODE>
__global__ void __launch_bounds__(NTHREADS, 2) mega(Params p) {
    __shared__ __attribute__((aligned(16))) char smem[SMEM_BYTES];
    __shared__ int s_item;
    __shared__ unsigned s_bar[4];
    const int tid = threadIdx.x, nblk = gridDim.x, bid = blockIdx.x;
    unsigned* bar = (unsigned*)(p.ws + WS_BAR);
    if constexpr (MODE < 0) {
        if (tid == 0) { s_bar[0] = 0u; s_bar[1] = 0u; bar_add(&bar[XB_XCNT(xcc_id())]); }
    }
    if constexpr (MODE < 0) {
        if (p.ws == nullptr) cg::this_grid().sync();
    }
    if (MODE < 0 || MODE == 0) {
        if (bid == 0 && tid < 16) ((int*)(p.ws + WS_CTR))[tid] = 0;
        if (bid == 0 && tid == 0) {
            const float** st = (const float**)(p.ws + WS_CTR + 128);
            st[0] = p.x_p; st[1] = p.x_s; st[2] = p.ln_g; st[3] = p.ln_b;
        }
        for (int it = bid; it < P0_TOTAL; it += nblk) phase0_item(p, it, smem);
    }
    if constexpr (MODE < 0) grid_barrier(bar, s_bar);
    if (MODE < 0 || MODE == 1) {
        for (int it = bid; it < MT / 16; it += nblk) phase1_item(p, it);
    }
    if constexpr (MODE < 0) grid_barrier(bar, s_bar);
    if (MODE < 0 || MODE == 2) {
        const int v = bid & 7, nbx = (nblk - v + 7) >> 3;
        for (int q = bid >> 3; q < P2_PER_X; q += nbx) {
            int mt, nt;
            const int kind = phase2_decode(v, q, mt, nt);
            if (kind == 1) phase2_tile_w(p, mt, nt, smem);
            else if (kind == 2) phase2_tile(p, mt, nt, smem);
        }
    }
    if constexpr (MODE < 0) grid_barrier(bar, s_bar);
    if (MODE < 0 || MODE == 3) {
        const int lane = tid & 63;
        const float d1 = wave_sum(p.lq1[lane] * p.lk1[lane]), d2 = wave_sum(p.lq2[lane] * p.lk2[lane]);
        const float lam = __expf(d1) - __expf(d2) + 0.2f;
        if (__builtin_amdgcn_readfirstlane((bid + (bid >> 8)) & 1)) __builtin_amdgcn_s_setprio(1);
        for (int k = 0; k < 8; ++k) {
            const int v = (bid + k) & 7;
            for (;;) {
                if (tid == 0) s_item = atomicAdd((int*)(p.ws + WS_CTR) + v, 1);
                __syncthreads();
                const int q = s_item;
                __syncthreads();
                if (q >= AT_PER_X) break;
                attn_item(p, smem, v, q, lam);
            }
        }
    }
    __builtin_amdgcn_s_setprio(0);
    if constexpr (MODE < 0) grid_barrier(bar, s_bar);
    if (MODE < 0 || MODE == 4) {
        Params p4;
        p4.out = p.out; p4.ws = p.ws;
        asm volatile("" : "+s"(p4.out), "+s"(p4.ws));
        if constexpr (MODE < 0) {
            const float* const* st = (const float* const*)(p.ws + WS_CTR + 128);
            p4.x_p = __builtin_nontemporal_load(st + 0); p4.x_s = __builtin_nontemporal_load(st + 1);
            p4.ln_g = __builtin_nontemporal_load(st + 2); p4.ln_b = __builtin_nontemporal_load(st + 3);
        } else { p4.x_p = p.x_p; p4.x_s = p.x_s; p4.ln_g = p.ln_g; p4.ln_b = p.ln_b; }
        for (int t = bid; t < 256; t += nblk) sample_out_task(p4, t, &s_item);
        for (int t = bid; t < MP / 64; t += nblk) phase4_tile(p4, t, smem);
    }
}

extern "C" void kernel_launch(void* const* d_in, const int* in_sizes, int n_in, void* d_out, int out_size, void* d_ws, size_t ws_size, hipStream_t stream) {
    static int grid = 0;
    if (grid == 0) {
        if (n_in != 21 || ws_size < WS_END) { fprintf(stderr, "kernel_launch: unexpected n_in %d / ws_size %zu (need %zu)\n", n_in, ws_size, (size_t)WS_END); grid = -1; return; }
        int dev = 0, cus = 0, per_cu = 0;
        hipGetDevice(&dev);
        hipDeviceGetAttribute(&cus, hipDeviceAttributeMultiprocessorCount, dev);
#if FUSED
        hipOccupancyMaxActiveBlocksPerMultiprocessor(&per_cu, mega<-1>, NTHREADS, 0);
#else
        per_cu = 2;
#endif
        if (per_cu < 1) { fprintf(stderr, "kernel_launch: occupancy query says %d blocks per CU\n", per_cu); grid = -1; return; }
        if (per_cu > 2) per_cu = 2;
        grid = cus * per_cu;
    }
    if (grid < 0) return;
    Params p{};
    p.x_p = (const float*)d_in[0]; p.x_s = (const float*)d_in[1]; p.ck_f = (const float*)d_in[2]; p.cv_f = (const float*)d_in[3]; p.clogf = (const float*)d_in[4];
    p.ck_d = (const float*)d_in[5]; p.cv_d = (const float*)d_in[6]; p.c_p = (const float*)d_in[7]; p.c_s = (const float*)d_in[8]; p.w_ada = (const float*)d_in[9];
    p.b_ada = (const float*)d_in[10]; p.w_in = (const float*)d_in[11]; p.b_f = (const float*)d_in[12]; p.lq1 = (const float*)d_in[13]; p.lk1 = (const float*)d_in[14];
    p.lq2 = (const float*)d_in[15]; p.lk2 = (const float*)d_in[16]; p.subln_g = (const float*)d_in[17]; p.w_out = (const float*)d_in[18]; p.ln_g = (const float*)d_in[19];
    p.ln_b = (const float*)d_in[20]; p.out = (float*)d_out; p.ws = (char*)d_ws;
    hipMemsetAsync((char*)d_ws + WS_BAR, 0, 64 * 256 + 1024, stream);
#if FUSED
    void* args[] = {&p};
    hipError_t e = hipLaunchCooperativeKernel((void*)mega<-1>, dim3(grid), dim3(NTHREADS), args, 0, stream);
    if (e != hipSuccess) fprintf(stderr, "cooperative launch failed: %s (grid %d)\n", hipGetErrorString(e), grid);
#else
    for (int r = 0; r < L0_REPS; ++r) mega<0><<<grid, NTHREADS, 0, stream>>>(p);
    for (int r = 0; r < L1_REPS; ++r) mega<1><<<grid, NTHREADS, 0, stream>>>(p);
    for (int r = 0; r < L2_REPS; ++r) mega<2><<<grid, NTHREADS, 0, stream>>>(p);
    mega<3><<<grid, NTHREADS, 0, stream>>>(p);
    for (int r = 0; r < L4_REPS; ++r) mega<4><<<grid, NTHREADS, 0, stream>>>(p);
#endif
}
```
